# Optimizing an MI355X kernel written in HIP

```python
import math
import jax, jax.numpy as jnp
from jax import lax
import numpy as np


D_MODEL = 1024
BATCH = 4
SEQ = 8192
DEPTH = 4

N_MIXERS = 3
MEM_LEN = 256
EPS = 1e-6

A_HEADS = 4
A_DQK = D_MODEL // 8
A_DV = D_MODEL // A_HEADS
A_CHUNK = 64
A_CONV = 4
A_IN = 2 * A_HEADS * A_DQK + 2 * A_HEADS * A_DV + 2 * A_HEADS

B_HEADS = 4
B_DK = D_MODEL // 8
B_DV = D_MODEL // B_HEADS
B_RANK = 16
B_TAU = 16.0
B_CHUNK = 32
B_IN = 2 * B_HEADS * B_DK + 2 * B_HEADS * B_DV + B_RANK

C_GROUP = 16
C_GROUPS = D_MODEL // C_GROUP
C_STATE = 64
DT_MIN = 1e-3
DT_MAX = 1e-1

X_HEADS = 4
X_DH = D_MODEL // X_HEADS

D_FF = ((8 * D_MODEL + 3 * 256 - 1) // (3 * 256)) * 256

kernel_name = 'hybrid_mlstm_gla_s5_xattn_swiglu'

F32 = jnp.float32


def rmsnorm(x, g):
    xf = x.astype(F32)
    xf = xf * lax.rsqrt(jnp.mean(xf * xf, axis=-1, keepdims=True) + EPS)
    return (xf * g.astype(F32)).astype(x.dtype)


def head_rmsnorm(h, g):
    h = h * lax.rsqrt(jnp.mean(h * h, axis=-1, keepdims=True) + EPS)
    return h.reshape(h.shape[0], h.shape[1], -1) * g.astype(F32)


def causal_dwconv(x, w):
    K = w.shape[0]
    S = x.shape[1]
    xp = jnp.pad(x, ((0, 0), (K - 1, 0), (0, 0)))
    y = xp[:, 0:S] * w[0]
    for j in range(1, K):
        y = y + xp[:, j:j + S] * w[j]
    return y


def to_chunks(t, L):
    Bsz, S, H, d = t.shape
    return t.reshape(Bsz, S // L, L, H, d).transpose(1, 0, 3, 2, 4)


def from_chunks(t):
    nc, Bsz, H, L, d = t.shape
    return t.transpose(1, 0, 3, 2, 4).reshape(Bsz, nc * L, H, d)


def mlstm_mix(xn, w_in, conv_w, gate_b, norm_g, w_out):
    Bsz, S, _ = xn.shape
    H, dk, dv, L = A_HEADS, A_DQK, A_DV, A_CHUNK
    nc = S // L
    proj = xn @ w_in
    qk, v, o, g = jnp.split(proj, [2 * H * dk, 2 * H * dk + H * dv, 2 * H * dk + 2 * H * dv], axis=-1)
    qk = jax.nn.silu(causal_dwconv(qk, conv_w)).astype(F32)
    q = qk[..., :H * dk].reshape(Bsz, S, H, dk) * (dk ** -0.5)
    k = qk[..., H * dk:].reshape(Bsz, S, H, dk)
    v = v.astype(F32).reshape(Bsz, S, H, dv)
    g = g.astype(F32) + gate_b.astype(F32)
    i_pre = g[..., :H]
    log_f = jax.nn.log_sigmoid(g[..., H:])
    gate_chunks = lambda t: t.reshape(Bsz, nc, L, H).transpose(1, 0, 3, 2)
    causal = jnp.tril(jnp.ones((L, L), dtype=bool))

    def step(carry, inp):
        C, n, m = carry
        qc, kc, vc, ic, fc = inp
        b = jnp.cumsum(fc, axis=-1)
        dmat = b[..., :, None] - b[..., None, :] + ic[..., None, :]
        dmat = jnp.where(causal, dmat, -jnp.inf)
        inter = b + m[..., None]
        m_t = jnp.maximum(inter, jnp.max(dmat, axis=-1))
        w_intra = jnp.exp(dmat - m_t[..., None])
        w_inter = jnp.exp(inter - m_t)
        s = jnp.einsum('bhtd,bhsd->bhts', qc, kc) * w_intra
        num = jnp.einsum('bhts,bhsv->bhtv', s, vc) + w_inter[..., None] * jnp.einsum('bhtd,bhdv->bhtv', qc, C)
        den = jnp.sum(s, axis=-1) + w_inter * jnp.einsum('bhtd,bhd->bht', qc, n)
        h = num / jnp.maximum(jnp.abs(den), jnp.exp(-m_t))[..., None]
        g_tot = b[..., -1]
        a = g_tot[..., None] - b + ic
        m_new = jnp.maximum(g_tot + m, jnp.max(a, axis=-1))
        decay = jnp.exp(g_tot + m - m_new)
        wa = jnp.exp(a - m_new[..., None])
        C_new = decay[..., None, None] * C + jnp.einsum('bhs,bhsd,bhsv->bhdv', wa, kc, vc)
        n_new = decay[..., None] * n + jnp.einsum('bhs,bhsd->bhd', wa, kc)
        return (C_new, n_new, m_new), h

    init = (jnp.zeros((Bsz, H, dk, dv), F32), jnp.zeros((Bsz, H, dk), F32), jnp.zeros((Bsz, H), F32))
    _, h = lax.scan(step, init, (to_chunks(q, L), to_chunks(k, L), to_chunks(v, L),
                                 gate_chunks(i_pre), gate_chunks(log_f)))
    h = head_rmsnorm(from_chunks(h), norm_g) * jax.nn.sigmoid(o.astype(F32))
    return h.astype(xn.dtype) @ w_out


def gla_mix(xn, w_in, gate_w2, gate_b, norm_g, w_out):
    Bsz, S, _ = xn.shape
    H, dk, dv, L = B_HEADS, B_DK, B_DV, B_CHUNK
    proj = xn @ w_in
    q, k, v, r, g_low = jnp.split(proj, [H * dk, 2 * H * dk, 2 * H * dk + H * dv, 2 * H * dk + 2 * H * dv], axis=-1)
    log_a = jax.nn.log_sigmoid((g_low @ gate_w2 + gate_b).astype(F32)) / B_TAU
    q = q.astype(F32).reshape(Bsz, S, H, dk) * (dk ** -0.5)
    k = k.astype(F32).reshape(Bsz, S, H, dk)
    v = v.astype(F32).reshape(Bsz, S, H, dv)
    log_a = log_a.reshape(Bsz, S, H, dk)
    causal = jnp.tril(jnp.ones((L, L), dtype=bool))

    def step(state, inp):
        qc, kc, vc, lac = inp
        b = jnp.cumsum(lac, axis=2)
        rel = b[:, :, :, None, :] - b[:, :, None, :, :]
        rel = jnp.where(causal[:, :, None], rel, -jnp.inf)
        s = jnp.einsum('bhtd,bhsd,bhtsd->bhts', qc, kc, jnp.exp(rel))
        o = jnp.einsum('bhts,bhsv->bhtv', s, vc) + jnp.einsum('bhtd,bhdv->bhtv', qc * jnp.exp(b), state)
        b_last = b[:, :, -1:, :]
        k_dec = kc * jnp.exp(b_last - b)
        state = jnp.exp(b_last[:, :, 0, :])[..., None] * state + jnp.einsum('bhsd,bhsv->bhdv', k_dec, vc)
        return state, o

    _, o = lax.scan(step, jnp.zeros((Bsz, H, dk, dv), F32),
                    (to_chunks(q, L), to_chunks(k, L), to_chunks(v, L), to_chunks(log_a, L)))
    o = head_rmsnorm(from_chunks(o), norm_g) * jax.nn.silu(r.astype(F32))
    return o.astype(xn.dtype) @ w_out


def complex_affine_combine(e1, e2):
    ar1, ai1, br1, bi1 = e1
    ar2, ai2, br2, bi2 = e2
    ar = ar1 * ar2 - ai1 * ai2
    ai = ar1 * ai2 + ai1 * ar2
    br = ar2 * br1 - ai2 * bi1 + br2
    bi = ar2 * bi1 + ai2 * br1 + bi2
    return ar, ai, br, bi


def s5_mix(xn, w_in, lam_re, lam_im, log_dt, b_re, b_im, c_re, c_im, d_skip, w_gate, b_gate, w_out):
    Bsz, S, _ = xn.shape
    G, P, Hg = C_GROUPS, C_STATE, C_GROUP
    u = (xn @ w_in).astype(F32).reshape(Bsz, S, G, Hg)
    lr = lam_re.astype(F32)
    li = lam_im.astype(F32)
    dt = jnp.exp(log_dt.astype(F32))[:, None]
    mag = jnp.exp(lr * dt)
    ab_re = mag * jnp.cos(li * dt)
    ab_im = mag * jnp.sin(li * dt)
    den = lr * lr + li * li
    z_re = ((ab_re - 1.0) * lr + ab_im * li) / den
    z_im = (ab_im * lr - (ab_re - 1.0) * li) / den
    br = b_re.astype(F32)
    bi = b_im.astype(F32)
    bb_re = z_re[..., None] * br - z_im[..., None] * bi
    bb_im = z_re[..., None] * bi + z_im[..., None] * br
    bu_re = jnp.einsum('bsgh,gph->bsgp', u, bb_re)
    bu_im = jnp.einsum('bsgh,gph->bsgp', u, bb_im)
    a_re = jnp.broadcast_to(ab_re, (1, S, G, P))
    a_im = jnp.broadcast_to(ab_im, (1, S, G, P))
    _, _, s_re, s_im = lax.associative_scan(complex_affine_combine, (a_re, a_im, bu_re, bu_im), axis=1)
    y = (jnp.einsum('bsgp,ghp->bsgh', s_re, c_re.astype(F32))
         - jnp.einsum('bsgp,ghp->bsgh', s_im, c_im.astype(F32)))
    y = y + d_skip.astype(F32).reshape(G, Hg) * u
    y = jax.nn.gelu(y.reshape(Bsz, S, G * Hg)).astype(xn.dtype)
    y = y * jax.nn.sigmoid(y @ w_gate + b_gate)
    return y @ w_out


def cross_attn(xn, memn, w_q, w_kv, w_o):
    Bsz, S, D = xn.shape
    M = memn.shape[1]
    q = (xn @ w_q).reshape(Bsz, S, X_HEADS, X_DH)
    k, v = jnp.split(memn @ w_kv, 2, axis=-1)
    k = k.reshape(Bsz, M, X_HEADS, X_DH)
    v = v.reshape(Bsz, M, X_HEADS, X_DH)
    s = jnp.einsum('bshd,bmhd->bhsm', q, k).astype(F32) * (X_DH ** -0.5)
    p = jax.nn.softmax(s, axis=-1).astype(v.dtype)
    o = jnp.einsum('bhsm,bmhd->bshd', p, v).reshape(Bsz, S, D)
    return o @ w_o


def swiglu(xn, w_gate, w_up, w_down):
    return (jax.nn.silu(xn @ w_gate) * (xn @ w_up)) @ w_down


def setup_inputs(seed: int = 0) -> dict:
    key = jax.random.key(seed)
    ks = iter(jax.random.split(key, 64))

    def nrm(shape, scale):
        return jax.random.normal(next(ks), shape, F32) * scale

    def gain(shape):
        return 1.0 + nrm(shape, 0.02)

    D = D_MODEL
    n_a = len(range(0, DEPTH, N_MIXERS))
    n_b = len(range(1, DEPTH, N_MIXERS))
    n_c = len(range(2, DEPTH, N_MIXERS))
    d = {}
    d['x'] = nrm((BATCH, SEQ, D), 1.0)
    d['mem'] = nrm((BATCH, MEM_LEN, D), 1.0)
    d['norm_mix'] = gain((DEPTH, D))
    d['norm_x'] = gain((DEPTH, D))
    d['norm_ffn'] = gain((DEPTH, D))
    d['norm_mem'] = gain((D,))
    d['norm_final'] = gain((D,))
    d['a_w_in'] = nrm((n_a, D, A_IN), D ** -0.5)
    d['a_conv_w'] = nrm((n_a, A_CONV, 2 * A_HEADS * A_DQK), A_CONV ** -0.5)
    i_bias = nrm((n_a, A_HEADS), 0.1)
    f_bias = jnp.linspace(3.0, 6.0, A_HEADS, dtype=F32)[None, :] + nrm((n_a, A_HEADS), 0.1)
    d['a_gate_b'] = jnp.concatenate([i_bias, f_bias], axis=-1)
    d['a_norm'] = gain((n_a, A_HEADS * A_DV))
    d['a_w_out'] = nrm((n_a, A_HEADS * A_DV, D), (A_HEADS * A_DV) ** -0.5)
    d['b_w_in'] = nrm((n_b, D, B_IN), D ** -0.5)
    d['b_gate_w2'] = nrm((n_b, B_RANK, B_HEADS * B_DK), B_RANK ** -0.5)
    d['b_gate_b'] = nrm((n_b, B_HEADS * B_DK), 0.1)
    d['b_norm'] = gain((n_b, B_HEADS * B_DV))
    d['b_w_out'] = nrm((n_b, B_HEADS * B_DV, D), (B_HEADS * B_DV) ** -0.5)
    d['c_w_in'] = nrm((n_c, D, D), D ** -0.5)
    d['c_lam_re'] = -0.5 + nrm((n_c, C_GROUPS, C_STATE), 0.01)
    d['c_lam_im'] = math.pi * jnp.arange(C_STATE, dtype=F32)[None, None, :] + nrm((n_c, C_GROUPS, C_STATE), 0.01)
    d['c_log_dt'] = jax.random.uniform(next(ks), (n_c, C_GROUPS), F32, math.log(DT_MIN), math.log(DT_MAX))
    d['c_b_re'] = nrm((n_c, C_GROUPS, C_STATE, C_GROUP), (2 * C_GROUP) ** -0.5)
    d['c_b_im'] = nrm((n_c, C_GROUPS, C_STATE, C_GROUP), (2 * C_GROUP) ** -0.5)
    d['c_c_re'] = nrm((n_c, C_GROUPS, C_GROUP, C_STATE), 0.25)
    d['c_c_im'] = nrm((n_c, C_GROUPS, C_GROUP, C_STATE), 0.25)
    d['c_d'] = nrm((n_c, D), 0.5)
    d['c_w_gate'] = nrm((n_c, D, D), D ** -0.5)
    d['c_b_gate'] = nrm((n_c, D), 0.02)
    d['c_w_out'] = nrm((n_c, D, D), D ** -0.5)
    d['x_w_q'] = nrm((DEPTH, D, D), D ** -0.5)
    d['x_w_kv'] = nrm((DEPTH, D, 2 * D), D ** -0.5)
    d['x_w_o'] = nrm((DEPTH, D, D), D ** -0.5)
    d['f_w_gate'] = nrm((DEPTH, D, D_FF), D ** -0.5)
    d['f_w_up'] = nrm((DEPTH, D, D_FF), D ** -0.5)
    d['f_w_down'] = nrm((DEPTH, D_FF, D), D_FF ** -0.5)
    return d


def reference(x, mem, norm_mix, norm_x, norm_ffn, norm_mem, norm_final,
              a_w_in, a_conv_w, a_gate_b, a_norm, a_w_out,
              b_w_in, b_gate_w2, b_gate_b, b_norm, b_w_out,
              c_w_in, c_lam_re, c_lam_im, c_log_dt, c_b_re, c_b_im, c_c_re, c_c_im,
              c_d, c_w_gate, c_b_gate, c_w_out,
              x_w_q, x_w_kv, x_w_o,
              f_w_gate, f_w_up, f_w_down):
    memn = rmsnorm(mem, norm_mem)
    h = x
    for i in range(DEPTH):
        kind = i % N_MIXERS
        j = i // N_MIXERS
        hn = rmsnorm(h, norm_mix[i])
        if kind == 0:
            h = h + mlstm_mix(hn, a_w_in[j], a_conv_w[j], a_gate_b[j], a_norm[j], a_w_out[j])
        elif kind == 1:
            h = h + gla_mix(hn, b_w_in[j], b_gate_w2[j], b_gate_b[j], b_norm[j], b_w_out[j])
        else:
            h = h + s5_mix(hn, c_w_in[j], c_lam_re[j], c_lam_im[j], c_log_dt[j], c_b_re[j], c_b_im[j],
                           c_c_re[j], c_c_im[j], c_d[j], c_w_gate[j], c_b_gate[j], c_w_out[j])
        h = h + cross_attn(rmsnorm(h, norm_x[i]), memn, x_w_q[i], x_w_kv[i], x_w_o[i])
        h = h + swiglu(rmsnorm(h, norm_ffn[i]), f_w_gate[i], f_w_up[i], f_w_down[i])
    return rmsnorm(h, norm_final)
```

```cpp
#include <hip/hip_runtime.h>
#include <hip/hip_cooperative_groups.h>
#include <cstdio>
namespace cg = cooperative_groups;

typedef unsigned short u16;
typedef short bf16x8 __attribute__((ext_vector_type(8))) __attribute__((may_alias));
typedef short bf16x4 __attribute__((ext_vector_type(4))) __attribute__((may_alias));
typedef float f32x4 __attribute__((ext_vector_type(4))) __attribute__((may_alias));
typedef unsigned u32x4 __attribute__((ext_vector_type(4))) __attribute__((may_alias));
typedef unsigned u32x2 __attribute__((ext_vector_type(2))) __attribute__((may_alias));
#define LAS __attribute__((address_space(3)))
#define DEVI __device__ __forceinline__

constexpr int T_TOK = 32768, DM = 1024, SEQ = 8192;
constexpr int LDS_MAIN = 155648;
constexpr int LDS_BYTES = LDS_MAIN + 16;
constexpr int CH = 128;
constexpr int NCH = SEQ / CH;
constexpr int LP = 136;

constexpr size_t MiB = 1ull << 20;
constexpr size_t SZ_AIN = 3328ull * 1024 * 2, SZ_SQ = 1024ull * 1024 * 2, SZ_FGU = 5632ull * 1024 * 2, SZ_FD = 1024ull * 2816 * 2;
constexpr size_t OFF_W_AIN = 0;
constexpr size_t OFF_W_AOUT = OFF_W_AIN + 2 * SZ_AIN;
constexpr size_t OFF_W_BIN = OFF_W_AOUT + 2 * SZ_SQ;
constexpr size_t OFF_W_BOUT = OFF_W_BIN + SZ_AIN;
constexpr size_t OFF_W_CIN = OFF_W_BOUT + SZ_SQ;
constexpr size_t OFF_W_CGATE = OFF_W_CIN + SZ_SQ;
constexpr size_t OFF_W_COUT = OFF_W_CGATE + SZ_SQ;
constexpr size_t OFF_W_XQ = OFF_W_COUT + SZ_SQ;
constexpr size_t OFF_W_XKV = OFF_W_XQ + 4 * SZ_SQ;
constexpr size_t OFF_W_XO = OFF_W_XKV + 8 * SZ_SQ;
constexpr size_t OFF_W_FGU = OFF_W_XO + 4 * SZ_SQ;
constexpr size_t OFF_W_FD = OFF_W_FGU + 4 * SZ_FGU;
constexpr size_t OFF_MEMN = OFF_W_FD + 4 * SZ_FD;
constexpr size_t OFF_KBUF = OFF_MEMN + SZ_SQ;
constexpr size_t OFF_VT = OFF_KBUF + 4 * SZ_SQ;
constexpr size_t OFF_HN = OFF_VT + 4 * SZ_SQ;
constexpr size_t OFF_PROJ = OFF_HN + 64 * MiB;
constexpr size_t OFF_STATES = OFF_PROJ + 192 * MiB;
constexpr size_t OFF_GATES = OFF_STATES + 64 * MiB;
constexpr size_t OFF_DN = OFF_GATES + 2 * MiB;
constexpr size_t OFF_DEC = OFF_DN + MiB / 2;
constexpr size_t OFF_KC = OFF_DEC + MiB / 2;
constexpr size_t OFF_APOW = OFF_KC + 2 * MiB;
constexpr size_t OFF_BB = OFF_APOW + 5 * MiB / 4;
constexpr size_t OFF_BAR = OFF_BB + MiB / 2;
constexpr size_t OFF_SSQ = OFF_BAR + 16384;
constexpr size_t OFF_GBT = OFF_SSQ + 13ull * 32768 * 16;
constexpr size_t OFF_VWBT = OFF_GBT + 8 * MiB;
constexpr size_t WS_END = OFF_VWBT + 8 * MiB;
constexpr size_t OFF_UEXT = OFF_PROJ, OFF_SEND = OFF_PROJ + 80 * MiB, OFF_Z = OFF_PROJ + 112 * MiB;
constexpr size_t OFF_HB = OFF_PROJ, OFF_XO = OFF_PROJ + 64 * MiB, OFF_XQ = OFF_PROJ + 128 * MiB;
constexpr size_t OFF_BTY = OFF_STATES, OFF_BTG = OFF_STATES + 40 * MiB;

struct Params { const float* in[35]; float* out; unsigned char* ws; };

DEVI int otid() { int t = threadIdx.x; asm volatile("" : "+v"(t)); return t; }
DEVI int obid() { int t = blockIdx.x; asm volatile("" : "+s"(t)); return t; }
DEVI unsigned char* oput(unsigned char* q) { asm volatile("" : "+s"(q)); return q; }
DEVI float bf2f(u16 b) { return __uint_as_float(((unsigned)b) << 16); }
typedef __bf16 bf16v2_t __attribute__((ext_vector_type(2)));
typedef float f32v2_t __attribute__((ext_vector_type(2)));
DEVI unsigned cvt_pk(float lo, float hi) { f32v2_t f = {lo, hi}; bf16v2_t v = __builtin_convertvector(f, bf16v2_t); return __builtin_bit_cast(unsigned, v); }
DEVI u16 f2bf(float f) { return (u16)(cvt_pk(f, 0.f) & 0xffffu); }
DEVI u32x2 pk4(f32x4 v) { u32x2 r; r.x = cvt_pk(v[0], v[1]); r.y = cvt_pk(v[2], v[3]); return r; }
DEVI float sigmoidf_(float x) { return __builtin_amdgcn_rcpf(1.f + __expf(-x)); }
DEVI float siluf_(float x) { return x * __builtin_amdgcn_rcpf(1.f + __expf(-x)); }
DEVI float logsigf_(float x) { return fminf(x, 0.f) - __logf(1.f + __expf(-fabsf(x))); }
DEVI float gelu_tanh(float x) { const float u = 0.7978845608028654f * (x + 0.044715f * x * x * x); return x * sigmoidf_(2.f * u); }
DEVI void lds_barrier() { asm volatile("s_waitcnt lgkmcnt(0)\n\ts_barrier" ::: "memory"); }
DEVI f32x4 mfma16(bf16x8 a, bf16x8 b, f32x4 c) { return __builtin_amdgcn_mfma_f32_16x16x32_bf16(a, b, c, 0, 0, 0); }

constexpr int BM = 256, BK = 64, HALF = 128, HTB = HALF * BK * 2, NXCD = 8, WGM = 8;
DEVI int lds_byte(int r, int c) { const int st = (r >> 4) * 2 + (c >> 5), rr = r & 15, cc = c & 31, ob = rr * 64 + cc * 2; return st * 1024 + (ob ^ (((ob >> 9) & 1) << 5)); }
DEVI void stage_rc(int b, int& R, int& C) { const int st = b / 1024, sb = b % 1024, swz = sb ^ (((sb >> 9) & 1) << 5); R = (st >> 1) * 16 + swz / 64; C = (st & 1) * 32 + (swz % 64) / 2; }

DEVI int perm32(int rho) { const int n = rho >> 4, i = rho & 15; return 8 * (i >> 2) + 4 * n + (i & 3); }
struct Unit { int pm, pn, b; };
struct Gemm { const u16* A; const u16* Bt; int lda, ldb, K, nM, nN, nB; size_t sA, sB;
    int split = 0; size_t sA_lo = 0, sB_lo = 0;
    int pmsh = 31; size_t sBpm = 0; };
DEVI size_t gemm_offA(const Gemm& g, const Unit& u) { return g.split ? (size_t)(u.b >> 2) * g.sA + (size_t)(u.b & 3) * g.sA_lo : (size_t)u.b * g.sA; }
DEVI size_t gemm_offB(const Gemm& g, const Unit& u) { return (g.split ? (size_t)(u.b >> 2) * g.sB + (size_t)(u.b & 3) * g.sB_lo : (size_t)u.b * g.sB) + (size_t)(u.pm >> g.pmsh) * g.sBpm; }

DEVI bool unit_next(const Gemm& g, int i, Unit& u) {
    const int nwg = g.nM * g.nN; const long L = (long)i * gridDim.x + obid();
    if (L >= (long)nwg * g.nB) return false;
    u.b = (int)(L / nwg); int wgid = (int)(L % nwg);
    { const int q = nwg / NXCD, r = nwg % NXCD, xcd = wgid % NXCD, off = wgid / NXCD; wgid = (xcd < r ? xcd * (q + 1) : r * (q + 1) + (xcd - r) * q) + off; }
    const int nig = WGM * g.nN, gid = wgid / nig, fm = gid * WGM, gsz = (g.nM - fm) < WGM ? (g.nM - fm) : WGM;
    u.pm = fm + ((wgid % nig) % gsz); u.pn = (wgid % nig) / gsz; return true;
}

DEVI u32x4 pk8(f32x4 a, f32x4 b);
template <class Epi>
DEVI void gemm_phase(LAS unsigned char* lds, const Gemm g, const Epi& E) {
    const int tid = otid(), wid = __builtin_amdgcn_readfirstlane(tid >> 6), lane = tid & 63, wr = wid >> 2, wc = wid & 3, fr = lane & 15, fq = lane >> 4;
    const int nt = g.K / BK;
    unsigned voffA[2], voffB[2];
#pragma unroll
    for (int i = 0; i < 2; ++i) { int R, C; stage_rc(tid * 16 + i * 8192, R, C); voffA[i] = (unsigned)(R * g.lda + C) * 2u; const int Rb = Epi::PERM ? ((R & ~31) + perm32(R & 31)) : R; voffB[i] = (unsigned)(Rb * g.ldb + C) * 2u; }
    const size_t kstep = (size_t)(BK * 2);
    const size_t hstepA = (size_t)HALF * g.lda * 2, hstepB = (size_t)HALF * g.ldb * 2;
    const size_t tstepA = 2 * hstepA, tstepB = 2 * hstepB;
    const unsigned ldsw = (unsigned)wid * 1024u;
    const int aoff = lds_byte(wr * 64 + fr, fq * 8), boff = lds_byte(wc * 32 + fr, fq * 8);
#define PG8_SA(b, h) (((b) * 2 + (h)) * HTB)
#define PG8_SB(b, h) ((4 + (b) * 2 + (h)) * HTB)
#define PG8_STAGE(bufoff, gbase, voff) do { _Pragma("unroll") for (int _i = 0; _i < 2; ++_i) \
        __builtin_amdgcn_global_load_lds((const unsigned*)((const char*)(gbase) + (voff)[_i]), (LAS unsigned*)(lds + (bufoff) + ldsw + _i * 8192), 16, 0, 0); } while (0)
#define PG8_LDA(dst, b, h) do { _Pragma("unroll") for (int m = 0; m < 4; ++m) _Pragma("unroll") for (int k = 0; k < 2; ++k) dst[m][k] = *(const LAS bf16x8*)(lds + PG8_SA(b, h) + aoff + m * 2048 + k * 1024); } while (0)
#define PG8_LDB(dst, b, h) do { _Pragma("unroll") for (int n = 0; n < 2; ++n) _Pragma("unroll") for (int k = 0; k < 2; ++k) dst[n][k] = *(const LAS bf16x8*)(lds + PG8_SB(b, h) + boff + n * 2048 + k * 1024); } while (0)
#define PG8_MMA(ai, bj, At, Bt) do { __builtin_amdgcn_s_setprio(1); _Pragma("unroll") for (int m = 0; m < 4; ++m) _Pragma("unroll") for (int n = 0; n < 2; ++n) _Pragma("unroll") for (int k = 0; k < 2; ++k) \
        acc[ai][bj][m][n] = __builtin_amdgcn_mfma_f32_16x16x32_bf16(Bt[n][k], At[m][k], acc[ai][bj][m][n], 0, 0, 0); __builtin_amdgcn_s_setprio(0); } while (0)
#define PG8_WAIT_V(n) asm volatile("s_waitcnt vmcnt(" #n ")" ::: "memory")
#define PG8_WAIT_L(n) asm volatile("s_waitcnt lgkmcnt(" #n ")" ::: "memory")
#define PG8_BAR __builtin_amdgcn_s_barrier()
#define PG8_SCHED __builtin_amdgcn_sched_barrier(0)
    Unit cur, nxt; int ui = 0;
    if (!unit_next(g, 0, cur)) return;
    f32x4 acc[2][2][4][2];
#pragma unroll
    for (int a = 0; a < 2; ++a)
#pragma unroll
        for (int b = 0; b < 2; ++b)
#pragma unroll
            for (int m = 0; m < 4; ++m)
#pragma unroll
                for (int n = 0; n < 2; ++n) acc[a][b][m][n] = (f32x4){0.f, 0.f, 0.f, 0.f};
    bf16x8 At[4][2], B0[2][2], B1[2][2];
    const char* cA = (const char*)g.A + gemm_offA(g, cur) * 2 + (size_t)cur.pm * tstepA;
    const char* cB = (const char*)g.Bt + gemm_offB(g, cur) * 2 + (size_t)cur.pn * tstepB;
    PG8_STAGE(PG8_SB(0, 0), cB, voffB); PG8_STAGE(PG8_SA(0, 0), cA, voffA); PG8_STAGE(PG8_SB(0, 1), cB + hstepB, voffB); PG8_STAGE(PG8_SA(0, 1), cA + hstepA, voffA);
    if (wr == 1) PG8_BAR;
    PG8_WAIT_V(4); PG8_BAR;
    PG8_STAGE(PG8_SB(1, 0), cB + kstep, voffB); PG8_STAGE(PG8_SA(1, 0), cA + kstep, voffA); PG8_STAGE(PG8_SB(1, 1), cB + hstepB + kstep, voffB);
    PG8_WAIT_V(6); PG8_BAR;
    for (;;) {
        const bool has_next = unit_next(g, ui + 1, nxt);
        const char* nA = has_next ? (const char*)g.A + gemm_offA(g, nxt) * 2 + (size_t)nxt.pm * tstepA : cA;
        const char* nB = has_next ? (const char*)g.Bt + gemm_offB(g, nxt) * 2 + (size_t)nxt.pn * tstepB : cB;
        for (int t = 0; t < nt; t += 2) {
            const bool last = (t == nt - 2);
            const char* a1 = cA + (size_t)(t + 1) * kstep;
            const char* a2 = last ? nA : cA + (size_t)(t + 2) * kstep; const char* b2 = last ? nB : cB + (size_t)(t + 2) * kstep;
            const char* a3 = a2 + kstep; const char* b3 = b2 + kstep;
            PG8_LDB(B0, 0, 0); PG8_SCHED; PG8_LDA(At, 0, 0); PG8_STAGE(PG8_SA(1, 1), a1 + hstepA, voffA);
            PG8_WAIT_L(8); PG8_BAR; PG8_WAIT_L(0); PG8_MMA(0, 0, At, B0); PG8_BAR; PG8_SCHED;
            PG8_LDB(B1, 0, 1); PG8_STAGE(PG8_SB(0, 0), b2, voffB);
            PG8_BAR; PG8_WAIT_L(0); PG8_MMA(0, 1, At, B1); PG8_BAR;
            PG8_LDA(At, 0, 1); PG8_STAGE(PG8_SA(0, 0), a2, voffA);
            PG8_BAR; PG8_WAIT_L(0); PG8_MMA(1, 0, At, B0); PG8_BAR; PG8_SCHED;
            PG8_STAGE(PG8_SB(0, 1), b2 + hstepB, voffB);
            PG8_WAIT_V(6); PG8_BAR; PG8_MMA(1, 1, At, B1); PG8_BAR;
            PG8_LDB(B0, 1, 0); PG8_SCHED; PG8_LDA(At, 1, 0); PG8_STAGE(PG8_SA(0, 1), a2 + hstepA, voffA);
            PG8_WAIT_L(8); PG8_BAR; PG8_WAIT_L(0); PG8_MMA(0, 0, At, B0); PG8_BAR; PG8_SCHED;
            PG8_LDB(B1, 1, 1); PG8_STAGE(PG8_SB(1, 0), b3, voffB);
            PG8_BAR; PG8_WAIT_L(0); PG8_MMA(0, 1, At, B1); PG8_BAR;
            PG8_LDA(At, 1, 1); PG8_STAGE(PG8_SA(1, 0), a3, voffA);
            PG8_BAR; PG8_WAIT_L(0); PG8_MMA(1, 0, At, B0); PG8_BAR; PG8_SCHED;
            PG8_STAGE(PG8_SB(1, 1), b3 + hstepB, voffB);
            PG8_WAIT_V(6); PG8_BAR; PG8_MMA(1, 1, At, B1); PG8_BAR;
        }
        {
            const int row0 = cur.pm * BM + wr * 64 + fr, col0 = cur.pn * BM + wc * 32 + (Epi::PERM ? 8 : 4) * fq; constexpr int NST = Epi::PERM ? 4 : 16;
            float rsv[8];
            if constexpr (Epi::RS) { f32x4 q4[8];
#pragma unroll
                for (int i = 0; i < 8; ++i) q4[i] = *(const f32x4*)(E.ssq_in + (size_t)(row0 + (i >> 2) * HALF + (i & 3) * 16) * 4);
#pragma unroll
                for (int i = 0; i < 8; ++i) rsv[i] = rsqrtf((((q4[i][0] + q4[i][1]) + q4[i][2]) + q4[i][3]) * (1.f / DM) + 1e-6f); }
            if constexpr (Epi::SOFTMAX) {
                LAS float* red = (LAS float*)(lds + 131072);
#pragma unroll
                for (int ai = 0; ai < 2; ++ai)
#pragma unroll
                    for (int m = 0; m < 4; ++m) { const float sc = rsv[ai * 4 + m] * 0.0625f; float part = 0.f;
#pragma unroll
                        for (int bj = 0; bj < 2; ++bj)
#pragma unroll
                            for (int n = 0; n < 2; ++n)
#pragma unroll
                                for (int j = 0; j < 4; ++j) { const float e = __expf(fmaxf(fminf(acc[ai][bj][m][n][j] * sc, 80.f), -80.f)); acc[ai][bj][m][n][j] = e; part += e; }
                        part += __shfl_xor(part, 16); part += __shfl_xor(part, 32);
                        if (fq == 0) red[(wr * 4 + wc) * 128 + ai * 64 + m * 16 + fr] = part; }
                PG8_WAIT_L(0); PG8_BAR;
#pragma unroll
                for (int ai = 0; ai < 2; ++ai)
#pragma unroll
                    for (int m = 0; m < 4; ++m) { const LAS float* rr = red + wr * 512 + ai * 64 + m * 16 + fr;
                        const float inv = __builtin_amdgcn_rcpf(((rr[0] + rr[128]) + rr[256]) + rr[384]); const int r = row0 + ai * HALF + m * 16;
#pragma unroll
                        for (int bj = 0; bj < 2; ++bj) *(u32x4*)(E.P + (size_t)r * DM + col0 + bj * HALF) = pk8(acc[ai][bj][m][0] * inv, acc[ai][bj][m][1] * inv); }
            } else
#pragma unroll
            for (int am = 0; am < 4; ++am) {
                const int ai = am >> 1, m0 = (am & 1) * 2;
                f32x4 pre[2][2][2];
                if constexpr (Epi::PRE) {
#pragma unroll
                    for (int m = 0; m < 2; ++m)
#pragma unroll
                        for (int bj = 0; bj < 2; ++bj)
#pragma unroll
                            for (int n = 0; n < 2; ++n) pre[m][bj][n] = E.load(row0 + ai * HALF + (m0 + m) * 16, col0 + bj * HALF + n * NST);
                }
#pragma unroll
                for (int mm = 0; mm < 2; ++mm) {
                    const int m = m0 + mm;
                    const int r = row0 + ai * HALF + m * 16; float rs = 1.f, part = 0.f;
                    if constexpr (Epi::RS) rs = rsv[ai * 4 + m];
                    if constexpr (Epi::PAIR) E.pair8(cur.b, r, cur.pn * HALF + wc * 32 + 8 * fq, acc[ai][0][m][0] * rs, acc[ai][0][m][1] * rs, acc[ai][1][m][0] * rs, acc[ai][1][m][1] * rs);
                    else
#pragma unroll
                    for (int bj = 0; bj < 2; ++bj) {
                        const int c = col0 + bj * HALF; f32x4 v0 = acc[ai][bj][m][0], v1 = acc[ai][bj][m][1];
                        if constexpr (Epi::RS) { v0 = v0 * rs; v1 = v1 * rs; }
                        if constexpr (Epi::PRE) part += E.frag_pre8(cur.b, r, c, v0, v1, pre[mm][bj][0], pre[mm][bj][1]);
                        else if constexpr (Epi::PERM) E.frag8(cur.b, r, c, v0, v1);
                        else { E.frag(cur.b, r, c, v0); E.frag(cur.b, r, c + 16, v1); }
                    }
                    if constexpr (Epi::SSQ) { part += __shfl_xor(part, 16); part += __shfl_xor(part, 32); if (fq == 0) ((LAS float*)(lds + 131072))[(wr * 4 + wc) * 128 + ai * 64 + m * 16 + fr] = part; }
                }
            }
            if constexpr (Epi::SSQ) {
                PG8_WAIT_L(0); PG8_BAR;
                if (lane < 32) { const int rl = wc * 32 + lane; const LAS float* red = (const LAS float*)(lds + 131072) + wr * 512 + rl;
                    const float sum = ((red[0] + red[128]) + red[256]) + red[384];
                    E.ssq_out[(size_t)(cur.pm * BM + (rl >> 6) * HALF + wr * 64 + (rl & 63)) * 4 + cur.pn] = sum; }
            }
        }
        if (!has_next) break;
#pragma unroll
        for (int a = 0; a < 2; ++a)
#pragma unroll
            for (int b = 0; b < 2; ++b)
#pragma unroll
                for (int m = 0; m < 4; ++m)
#pragma unroll
                    for (int n = 0; n < 2; ++n) acc[a][b][m][n] = (f32x4){0.f, 0.f, 0.f, 0.f};
        cur = nxt; cA = nA; cB = nB; ++ui;
    }
    PG8_WAIT_V(0);
    if (wr == 0) PG8_BAR;
    PG8_BAR;
#undef PG8_SA
#undef PG8_SB
#undef PG8_STAGE
#undef PG8_LDA
#undef PG8_LDB
#undef PG8_MMA
#undef PG8_WAIT_V
#undef PG8_WAIT_L
#undef PG8_BAR
#undef PG8_SCHED
}

DEVI u32x4 pk8(f32x4 a, f32x4 b) { u32x4 w; w.x = cvt_pk(a[0], a[1]); w.y = cvt_pk(a[2], a[3]); w.z = cvt_pk(b[0], b[1]); w.w = cvt_pk(b[2], b[3]); return w; }
struct EpiBf16 { static constexpr bool PAIR = false, RS = true, SSQ = false, PRE = false, PERM = true, SOFTMAX = false; u16* O; int ldc; const float* ssq_in;
    DEVI void frag8(int, int r, int c, f32x4 v0, f32x4 v1) const { *(u32x4*)(O + (size_t)r * ldc + c) = pk8(v0, v1); } };
struct EpiInProj { static constexpr bool PAIR = false, RS = true, SSQ = false, PRE = false, PERM = true, SOFTMAX = false; u16* O; float* gates; int ngate; const float* ssq_in;
    DEVI void frag8(int, int r, int c, f32x4 v0, f32x4 v1) const {
        if (c < 3072) *(u32x4*)(O + (size_t)r * 3072 + c) = pk8(v0, v1);
        else if (c - 3072 < ngate) { float* gp = gates + (size_t)r * 16 + (c - 3072); *(f32x4*)gp = v0; *(f32x4*)(gp + 4) = v1; } } };
struct EpiResid { static constexpr bool PAIR = false, RS = false, SSQ = true, PRE = true, PERM = true, SOFTMAX = false; const float* hin; float* hout; u16* hb; float* ssq_out;
    DEVI f32x4 load(int r, int c) const { return *(const f32x4*)(hin + (size_t)r * DM + c); }
    DEVI float frag_pre8(int, int r, int c, f32x4 v0, f32x4 v1, f32x4 p0, f32x4 p1) const { const size_t o = (size_t)r * DM + c; const f32x4 h0 = p0 + v0, h1 = p1 + v1;
        *(f32x4*)(hout + o) = h0; *(f32x4*)(hout + o + 4) = h1; *(u32x4*)(hb + o) = pk8(h0, h1);
        return ((h0[0] * h0[0] + h0[1] * h0[1]) + (h0[2] * h0[2] + h0[3] * h0[3])) + ((h1[0] * h1[0] + h1[1] * h1[1]) + (h1[2] * h1[2] + h1[3] * h1[3])); } };
struct EpiSwiglu { static constexpr bool PAIR = true, RS = true, SSQ = false, PRE = false, PERM = true, SOFTMAX = false; u16* O; const float* ssq_in;
    DEVI void pair8(int, int r, int c, f32x4 g0, f32x4 g1, f32x4 u0, f32x4 u1) const { f32x4 a, b;
#pragma unroll
        for (int j = 0; j < 4; ++j) { a[j] = siluf_(g0[j]) * u0[j]; b[j] = siluf_(g1[j]) * u1[j]; }
        *(u32x4*)(O + (size_t)r * 2816 + c) = pk8(a, b); } };
struct EpiKV { static constexpr bool PAIR = false, RS = false, SSQ = false, PRE = false, PERM = true, SOFTMAX = false; u16* kbuf; u16* vbuf;
    DEVI void frag8(int l, int r, int c, f32x4 v0, f32x4 v1) const { u16* base = c < 1024 ? kbuf : vbuf; *(u32x4*)(base + (size_t)l * 1024 * 1024 + (size_t)r * 1024 + (c & 1023)) = pk8(v0, v1); } };
struct EpiG { static constexpr bool PAIR = false, RS = false, SSQ = false, PRE = false, PERM = true, SOFTMAX = false; u16* G;
    DEVI void frag8(int bh, int r, int c, f32x4 v0, f32x4 v1) const { *(u32x4*)(G + ((size_t)(bh >> 2) * 1024 + (bh & 3) * 256 + r) * 1024 + c) = pk8(v0, v1); } };
struct EpiVW { static constexpr bool PAIR = false, RS = false, SSQ = false, PRE = false, PERM = true, SOFTMAX = false; u16* VW;
    DEVI void frag8(int bh, int r, int c, f32x4 v0, f32x4 v1) const { *(u32x4*)(VW + ((size_t)(bh >> 2) * 1024 + r) * 1024 + (bh & 3) * 256 + c) = pk8(v0, v1); } };
struct EpiSoftmax { static constexpr bool PAIR = false, RS = true, SSQ = false, PRE = false, PERM = true, SOFTMAX = true; u16* P; const float* ssq_in; };
struct EpiUext { static constexpr bool PAIR = false, RS = true, SSQ = false, PRE = false, PERM = true, SOFTMAX = false; u16* U; const float* ssq_in;
    DEVI void frag8(int, int r, int c, f32x4 v0, f32x4 v1) const { *(u32x4*)(U + ((size_t)(c >> 4) * 1024 + (r >> 5)) * 640 + (r & 31) * 16 + (c & 15)) = pk8(v0, v1); } };
struct EpiSend { static constexpr bool PAIR = false, RS = false, SSQ = false, PRE = false, PERM = false, SOFTMAX = false; float* S;
    DEVI void frag(int g, int r, int c, f32x4 v) const { if (c < 128) *(f32x4*)(S + ((size_t)g * 1024 + r) * 128 + c) = v; } };
struct EpiS5Y { static constexpr bool PAIR = false, RS = false, SSQ = false, PRE = false, PERM = true, SOFTMAX = false; u16* Y;
    DEVI void frag8(int g, int r, int c, f32x4 v0, f32x4 v1) const { f32x4 o0, o1;
#pragma unroll
        for (int j = 0; j < 4; ++j) { o0[j] = gelu_tanh(v0[j]); o1[j] = gelu_tanh(v1[j]); }
        *(u32x4*)(Y + ((size_t)r * 32 + (c >> 4)) * DM + g * 16 + (c & 15)) = pk8(o0, o1); } };
struct EpiS5Gate { static constexpr bool PAIR = false, RS = false, SSQ = false, PRE = true, PERM = true, SOFTMAX = false; const u16* Y; const float* bg; u16* Z;
    DEVI f32x4 load(int r, int c) const { const bf16x4 y = *(const bf16x4*)(Y + (size_t)r * DM + c); return (f32x4){bf2f((u16)y[0]), bf2f((u16)y[1]), bf2f((u16)y[2]), bf2f((u16)y[3])}; }
    DEVI float frag_pre8(int, int r, int c, f32x4 v0, f32x4 v1, f32x4 y0, f32x4 y1) const { const f32x4 b0 = *(const f32x4*)(bg + c), b1 = *(const f32x4*)(bg + c + 4); f32x4 z0, z1;
#pragma unroll
        for (int j = 0; j < 4; ++j) { z0[j] = y0[j] * sigmoidf_(v0[j] + b0[j]); z1[j] = y1[j] * sigmoidf_(v1[j] + b1[j]); }
        *(u32x4*)(Z + (size_t)r * DM + c) = pk8(z0, z1); return 0.f; } };

DEVI void convT(const float* src, int K, int N, u16* dst, int Npad, int mode, const float* gk, float* tile, int first) {
    const int tid = otid(), ntk = K / 64, ntn = Npad / 64;
    for (int ti = first; ti < ntk * ntn; ti += gridDim.x) {
        const int k0 = (ti % ntk) * 64, n0 = (ti / ntk) * 64;
        for (int i = tid; i < 1024; i += 512) { const int kk = i >> 4, n4 = (i & 15) * 4, n = n0 + n4;
            f32x4 v = (f32x4){0.f, 0.f, 0.f, 0.f}; if (n < N) { v = *(const f32x4*)(src + (size_t)(k0 + kk) * N + n); if (gk) v = v * gk[k0 + kk]; }
            float* tp = tile + kk * 65 + n4; tp[0] = v[0]; tp[1] = v[1]; tp[2] = v[2]; tp[3] = v[3]; }
        __syncthreads();
        if (mode == 3) { const int kk = tid >> 3, n8 = (tid & 7) * 8; const float* tp = tile + kk * 65 + n8;
          u32x4 w; w.x = cvt_pk(tp[0], tp[1]); w.y = cvt_pk(tp[2], tp[3]); w.z = cvt_pk(tp[4], tp[5]); w.w = cvt_pk(tp[6], tp[7]);
          *(u32x4*)(dst + (size_t)(k0 + kk) * N + n0 + n8) = w; }
        else { const int nn = tid >> 3, k8 = (tid & 7) * 8; const int n = n0 + nn;
          int row = n; if (mode == 1) row = 256 * (n >> 7) + (n & 127); else if (mode == 2) row = 256 * (n >> 7) + 128 + (n & 127);
          u32x4 w; w.x = cvt_pk(tile[(k8 + 0) * 65 + nn], tile[(k8 + 1) * 65 + nn]); w.y = cvt_pk(tile[(k8 + 2) * 65 + nn], tile[(k8 + 3) * 65 + nn]);
          w.z = cvt_pk(tile[(k8 + 4) * 65 + nn], tile[(k8 + 5) * 65 + nn]); w.w = cvt_pk(tile[(k8 + 6) * 65 + nn], tile[(k8 + 7) * 65 + nn]);
          *(u32x4*)(dst + (size_t)row * K + k0 + k8) = w; }
        __syncthreads();
    }
}
DEVI void conv_job(const Params& p, int job, const float*& src, int& K, int& N, u16*& dst, int& Npad, int& mode, const float*& gk) {
    unsigned char* ws = p.ws; K = 1024; N = 1024; Npad = 1024; mode = 0; gk = nullptr;
    if (job < 2) { src = p.in[7] + (size_t)job * 1024 * 3080; N = 3080; Npad = 3328; dst = (u16*)(ws + OFF_W_AIN + job * SZ_AIN); gk = p.in[2] + 3 * job * DM; }
    else if (job < 4) { src = p.in[11] + (size_t)(job - 2) * 1024 * 1024; dst = (u16*)(ws + OFF_W_AOUT + (job - 2) * SZ_SQ); }
    else if (job == 4) { src = p.in[12]; N = 3088; Npad = 3328; dst = (u16*)(ws + OFF_W_BIN); gk = p.in[2] + 1 * DM; }
    else if (job == 5) { src = p.in[16]; dst = (u16*)(ws + OFF_W_BOUT); }
    else if (job == 6) { src = p.in[17]; dst = (u16*)(ws + OFF_W_CIN); gk = p.in[2] + 2 * DM; }
    else if (job == 7) { src = p.in[26]; dst = (u16*)(ws + OFF_W_CGATE); }
    else if (job == 8) { src = p.in[28]; dst = (u16*)(ws + OFF_W_COUT); }
    else if (job < 13) { const int i = job - 9; src = p.in[29] + (size_t)i * 1024 * 1024; dst = (u16*)(ws + OFF_W_XQ + i * SZ_SQ); gk = p.in[3] + i * DM; mode = 3; }
    else if (job < 17) { const int i = job - 13; src = p.in[30] + (size_t)i * 1024 * 2048; N = 2048; Npad = 2048; dst = (u16*)(ws + OFF_W_XKV + i * 2 * SZ_SQ); }
    else if (job < 21) { const int i = job - 17; src = p.in[31] + (size_t)i * 1024 * 1024; dst = (u16*)(ws + OFF_W_XO + i * SZ_SQ); }
    else if (job < 25) { const int i = job - 21; src = p.in[32] + (size_t)i * 1024 * 2816; N = 2816; Npad = 2816; mode = 1; dst = (u16*)(ws + OFF_W_FGU + i * SZ_FGU); gk = p.in[4] + i * DM; }
    else if (job < 29) { const int i = job - 25; src = p.in[33] + (size_t)i * 1024 * 2816; N = 2816; Npad = 2816; mode = 2; dst = (u16*)(ws + OFF_W_FGU + i * SZ_FGU); gk = p.in[4] + i * DM; }
    else { const int i = job - 29; src = p.in[34] + (size_t)i * 2816 * 1024; K = 2816; dst = (u16*)(ws + OFF_W_FD + i * SZ_FD); }
}

DEVI void rms_phase(const float* src, const float* g, u16* dst, int rows) {
    const int lane = otid() & 63, gw = obid() * 8 + (otid() >> 6), nw = gridDim.x * 8;
    f32x4 gv[4];
#pragma unroll
    for (int i = 0; i < 4; ++i) gv[i] = *(const f32x4*)(g + i * 256 + lane * 4);
    for (int r = gw; r < rows; r += nw) {
        const float* s = src + (size_t)r * DM; f32x4 v[4]; float ss = 0.f;
#pragma unroll
        for (int i = 0; i < 4; ++i) { v[i] = *(const f32x4*)(s + i * 256 + lane * 4); ss += v[i][0] * v[i][0] + v[i][1] * v[i][1] + v[i][2] * v[i][2] + v[i][3] * v[i][3]; }
#pragma unroll
        for (int o = 32; o > 0; o >>= 1) ss += __shfl_xor(ss, o);
        const float rs = rsqrtf(ss * (1.f / DM) + 1e-6f);
#pragma unroll
        for (int i = 0; i < 4; ++i) *(u32x2*)(dst + (size_t)r * DM + i * 256 + lane * 4) = pk4(v[i] * rs * gv[i]);
    }
}
DEVI void prep_phase(const float* src, u16* dst, float* ssq) {
    const int lane = otid() & 63, gw = obid() * 8 + (otid() >> 6), nw = gridDim.x * 8;
    for (int r = gw; r < T_TOK; r += nw) {
        const float* s = src + (size_t)r * DM; f32x4 v[4]; float ss = 0.f;
#pragma unroll
        for (int i = 0; i < 4; ++i) { v[i] = *(const f32x4*)(s + i * 256 + lane * 4); ss += v[i][0] * v[i][0] + v[i][1] * v[i][1] + v[i][2] * v[i][2] + v[i][3] * v[i][3]; }
#pragma unroll
        for (int o = 32; o > 0; o >>= 1) ss += __shfl_xor(ss, o);
#pragma unroll
        for (int i = 0; i < 4; ++i) *(u32x2*)(dst + (size_t)r * DM + i * 256 + lane * 4) = pk4(v[i]);
        if (lane == 0) *(f32x4*)(ssq + (size_t)r * 4) = (f32x4){ss, 0.f, 0.f, 0.f};
    }
}
DEVI void rms_final(float* io, const float* g) {
    const int lane = otid() & 63, gw = obid() * 8 + (otid() >> 6), nw = gridDim.x * 8;
    f32x4 gv[4];
#pragma unroll
    for (int i = 0; i < 4; ++i) gv[i] = *(const f32x4*)(g + i * 256 + lane * 4);
    for (int r = gw; r < T_TOK; r += nw) {
        float* s = io + (size_t)r * DM; f32x4 v[4]; float ss = 0.f;
#pragma unroll
        for (int i = 0; i < 4; ++i) { v[i] = *(const f32x4*)(s + i * 256 + lane * 4); ss += v[i][0] * v[i][0] + v[i][1] * v[i][1] + v[i][2] * v[i][2] + v[i][3] * v[i][3]; }
#pragma unroll
        for (int o = 32; o > 0; o >>= 1) ss += __shfl_xor(ss, o);
        const float rs = rsqrtf(ss * (1.f / DM) + 1e-6f);
#pragma unroll
        for (int i = 0; i < 4; ++i) *(f32x4*)(s + i * 256 + lane * 4) = v[i] * rs * gv[i];
    }
}

constexpr int KVP = 264;
DEVI void attn_stage(u16* img, const u16* src, int rstride, int tid) {
#pragma unroll
    for (int it = 0; it < 2; ++it) { u32x4 v[8];
#pragma unroll
        for (int k = 0; k < 8; ++k) { const int i = tid + (it * 8 + k) * 512, r = i >> 5, c8 = (i & 31) * 8; v[k] = *(const u32x4*)(src + (size_t)r * rstride + c8); }
#pragma unroll
        for (int k = 0; k < 8; ++k) { const int i = tid + (it * 8 + k) * 512, r = i >> 5, c8 = (i & 31) * 8; *(u32x4*)(img + r * KVP + c8) = v[k]; } }
}
DEVI void attn_phase(unsigned char* smem, const u16* Q, const u16* Kb, const u16* Vt, u16* O) {
    const int tid = otid(), wid = tid >> 6, lane = tid & 63, fr = lane & 15, fq = lane >> 4;
    u16* img = (u16*)smem;
    for (int item = obid(); item < 1024; item += gridDim.x) {
        const int qb = item & 63, bh = item >> 6, h = bh & 3, b = bh >> 2;
        lds_barrier();
        attn_stage(img, Kb + (size_t)(b * 256) * DM + h * 256, DM, tid);
        lds_barrier();
        bf16x8 pb[1][8]; float inv[1];
#pragma unroll
        for (int rb = 0; rb < 1; ++rb) {
            const size_t qrow = (size_t)b * SEQ + qb * 128 + rb * 128 + wid * 16 + fr;
            const u16* q = Q + qrow * DM + h * 256 + fq * 8;
            bf16x8 qf[8];
#pragma unroll
            for (int ks = 0; ks < 8; ++ks) qf[ks] = *(const bf16x8*)(q + ks * 32);
            f32x4 s[16];
#pragma unroll
            for (int kt = 0; kt < 16; ++kt) { s[kt] = (f32x4){0.f, 0.f, 0.f, 0.f};
#pragma unroll
                for (int ks = 0; ks < 8; ++ks) { const bf16x8 a = *(const bf16x8*)(img + (kt * 16 + fr) * KVP + ks * 32 + fq * 8); s[kt] = mfma16(a, qf[ks], s[kt]); } }
            float mx = -3.0e38f;
#pragma unroll
            for (int kt = 0; kt < 16; ++kt)
#pragma unroll
                for (int j = 0; j < 4; ++j) mx = fmaxf(mx, s[kt][j]);
            mx = fmaxf(mx, __shfl_xor(mx, 16)); mx = fmaxf(mx, __shfl_xor(mx, 32));
            const float sc = 0.0625f * 1.4426950408889634f; float sum = 0.f;
#pragma unroll
            for (int kt = 0; kt < 16; ++kt)
#pragma unroll
                for (int j = 0; j < 4; ++j) { const float e = __builtin_amdgcn_exp2f((s[kt][j] - mx) * sc); s[kt][j] = e; sum += e; }
            sum += __shfl_xor(sum, 16); sum += __shfl_xor(sum, 32);
            inv[rb] = 1.f / sum;
#pragma unroll
            for (int ks = 0; ks < 8; ++ks) { u32x4 w; w.x = cvt_pk(s[2 * ks][0], s[2 * ks][1]); w.y = cvt_pk(s[2 * ks][2], s[2 * ks][3]); w.z = cvt_pk(s[2 * ks + 1][0], s[2 * ks + 1][1]); w.w = cvt_pk(s[2 * ks + 1][2], s[2 * ks + 1][3]);
                pb[rb][ks] = __builtin_bit_cast(bf16x8, w); }
        }
        lds_barrier();
        attn_stage(img, Vt + (size_t)(b * 4 + h) * 256 * 256, 256, tid);
        lds_barrier();
#pragma unroll
        for (int rb = 0; rb < 1; ++rb) {
            const size_t qrow = (size_t)b * SEQ + qb * 128 + rb * 128 + wid * 16 + fr;
            u16* orow = O + qrow * DM + h * 256 + fq * 8;
            const int prow = 8 * (fr >> 2) + (fr & 3);
#pragma unroll
            for (int dp = 0; dp < 8; ++dp) { f32x4 o0 = (f32x4){0.f, 0.f, 0.f, 0.f}, o1 = o0;
#pragma unroll
                for (int ks = 0; ks < 8; ++ks) { const u16* vp = img + (dp * 32 + prow) * KVP + ks * 32 + fq * 4;
                    { const u32x2 lo = *(const u32x2*)(vp), hi = *(const u32x2*)(vp + 16); u32x4 w; w.x = lo.x; w.y = lo.y; w.z = hi.x; w.w = hi.y; o0 = mfma16(__builtin_bit_cast(bf16x8, w), pb[rb][ks], o0); }
                    { const u32x2 lo = *(const u32x2*)(vp + 4 * KVP), hi = *(const u32x2*)(vp + 4 * KVP + 16); u32x4 w; w.x = lo.x; w.y = lo.y; w.z = hi.x; w.w = hi.y; o1 = mfma16(__builtin_bit_cast(bf16x8, w), pb[rb][ks], o1); } }
                *(u32x4*)(orow + dp * 32) = pk8(o0 * inv[rb], o1 * inv[rb]); }
        }
    }
}

constexpr int L_SM = 0;
constexpr int VQP = 68;
constexpr int L_QS = 16384, L_KS = L_QS + 128 * LP * 2, L_SS = L_KS + 128 * LP * 2, L_VT = L_SS + 128 * LP * 2, L_CT = L_VT + 64 * LP * 2;
constexpr int VSP = 264;
constexpr int L_VTF = 16384, L_KT = 86016;

struct MixArgs { const u16* proj; const float* gates; const float* convw; const float* gateb; const float* w2; const float* normg; u16* states; float* dn; float* dec; u16* y; };

DEVI void mlstm_gates(const MixArgs& a, int h, size_t tok0, float* fB, float* fI) {
    const int tid = otid();
    if (tid < 128) { const float* g = a.gates + (tok0 + tid) * 16; fI[tid] = g[h] + a.gateb[h]; fB[tid] = logsigf_(g[4 + h] + a.gateb[4 + h]); }
    lds_barrier();
    if (tid < 64) { float x0 = fB[2 * tid], x1 = fB[2 * tid + 1]; float s = x0 + x1;
#pragma unroll
        for (int o = 1; o < 64; o <<= 1) { const float t = __shfl_up(s, o); if (tid >= o) s += t; }
        fB[2 * tid] = s - x1; fB[2 * tid + 1] = s; }
    lds_barrier();
}
DEVI void mlstm_conv8(const MixArgs& a, size_t tok, int pos, int ch0, float* out) {
    float accv[8];
#pragma unroll
    for (int i = 0; i < 8; ++i) accv[i] = 0.f;
#pragma unroll
    for (int j = 0; j < 4; ++j) { if (pos - 3 + j >= 0) { const bf16x8 x = *(const bf16x8*)(a.proj + (tok - 3 + j) * 3072 + ch0);
            const f32x4 w0 = *(const f32x4*)(a.convw + j * 1024 + ch0), w1 = *(const f32x4*)(a.convw + j * 1024 + ch0 + 4);
#pragma unroll
            for (int i = 0; i < 4; ++i) { accv[i] += w0[i] * bf2f((u16)x[i]); accv[4 + i] += w1[i] * bf2f((u16)x[4 + i]); } } }
#pragma unroll
    for (int i = 0; i < 8; ++i) out[i] = siluf_(accv[i]);
}
DEVI float gla_la(const float* gl, int t, const float* w2r, float gb) { float x = gb;
#pragma unroll
    for (int r = 0; r < 16; ++r) x += gl[t * 16 + r] * w2r[r];
    return logsigf_(x) * (1.f / 16.f); }

typedef short s4v_t __attribute__((ext_vector_type(4)));
DEVI bf16x8 tr_frag(const u16* img, int RS, int r0, int c0, int lane) {
    const u16* a = img + (r0 + (lane >> 4) * 8 + ((lane & 15) >> 2)) * RS + c0 + 4 * (lane & 3);
    const s4v_t lo = __builtin_amdgcn_ds_read_tr16_b64_v4i16((LAS s4v_t*)a);
    const s4v_t hi = __builtin_amdgcn_ds_read_tr16_b64_v4i16((LAS s4v_t*)(a + 4 * RS));
    bf16x8 r; r[0] = lo[0]; r[1] = lo[1]; r[2] = lo[2]; r[3] = lo[3]; r[4] = hi[0]; r[5] = hi[1]; r[6] = hi[2]; r[7] = hi[3]; return r;
}
DEVI bf16x8 tr_frag_p(const u16* img, int RS, int r0, int n, int lane) {
    const u16* a = img + (r0 + (lane >> 4) * 8 + ((lane & 15) >> 2)) * RS + 32 * (n >> 1) + 8 * (lane & 3) + 4 * (n & 1);
    const s4v_t lo = __builtin_amdgcn_ds_read_tr16_b64_v4i16((LAS s4v_t*)a);
    const s4v_t hi = __builtin_amdgcn_ds_read_tr16_b64_v4i16((LAS s4v_t*)(a + 4 * RS));
    bf16x8 r; r[0] = lo[0]; r[1] = lo[1]; r[2] = lo[2]; r[3] = lo[3]; r[4] = hi[0]; r[5] = hi[1]; r[6] = hi[2]; r[7] = hi[3]; return r;
}

template <int KIND>
DEVI void mix_state_phase(unsigned char* smem, const MixArgs a) {
    const int tid = otid(), wid = tid >> 6, lane = tid & 63, fr = lane & 15, fq = lane >> 4;
    float* fB = (float*)(smem + L_SM); float* fI = fB + 128; float* fW = fI + 128; float* seg = fW + 128; float* gl = (float*)(smem + L_SM + 4096);
    u16* VTF = (u16*)(smem + L_VTF); u16* KT = (u16*)(smem + L_KT);
    for (int item = obid(); item < 16 * NCH; item += gridDim.x) {
        const int c = item % NCH, bh = item / NCH, h = bh & 3, b = bh >> 2; const size_t tok0 = (size_t)b * SEQ + c * CH;
        lds_barrier();
        if (KIND == 0) { mlstm_gates(a, h, tok0, fB, fI); if (tid < 128) fW[tid] = __expf(fB[127] - fB[tid] + fI[tid]); lds_barrier();
#pragma unroll 4
            for (int i = tid; i < 128 * 16; i += 512) { const int t = i >> 4, c8 = (i & 15) * 8; float v[8]; mlstm_conv8(a, tok0 + t, c * CH + t, 512 + h * 128 + c8, v); const float w = fW[t];
                u32x4 pw; pw.x = cvt_pk(v[0] * w, v[1] * w); pw.y = cvt_pk(v[2] * w, v[3] * w); pw.z = cvt_pk(v[4] * w, v[5] * w); pw.w = cvt_pk(v[6] * w, v[7] * w);
                *(u32x4*)(KT + t * LP + c8) = pw; }
        } else {
#pragma unroll
            for (int k = 0; k < 4; ++k) { const int i = tid + k * 512; gl[i] = a.gates[(tok0 + (i >> 4)) * 16 + (i & 15)]; }
            { u32x4 kk[4];
#pragma unroll
              for (int k = 0; k < 4; ++k) { const int i = tid + k * 512; kk[k] = *(const u32x4*)(a.proj + (tok0 + (i >> 4)) * 3072 + 512 + h * 128 + (i & 15) * 8); }
#pragma unroll
              for (int k = 0; k < 4; ++k) { const int i = tid + k * 512; *(u32x4*)(KT + (i >> 4) * LP + (i & 15) * 8) = kk[k]; } }
            lds_barrier();
            const int ch = tid & 127, sg = tid >> 7; float w2r[16];
#pragma unroll
            for (int r = 0; r < 16; ++r) w2r[r] = a.w2[r * 512 + h * 128 + ch];
            const float gb = a.gateb[h * 128 + ch]; float ssum = 0.f;
            for (int t = sg * 32; t < sg * 32 + 32; ++t) ssum += gla_la(gl, t, w2r, gb);
            seg[sg * 128 + ch] = ssum; lds_barrier();
            float Bc = 0.f, tot = 0.f;
#pragma unroll
            for (int s2 = 0; s2 < 4; ++s2) { const float v = seg[s2 * 128 + ch]; tot += v; if (s2 < sg) Bc += v; }
            for (int t = sg * 32; t < sg * 32 + 32; ++t) { Bc += gla_la(gl, t, w2r, gb);
                const float kv = bf2f(KT[t * LP + ch]); KT[t * LP + ch] = f2bf(kv * __expf(tot - Bc)); }
            if (sg == 0) a.dec[(size_t)item * 128 + ch] = __expf(tot);
        }
        { u32x4 vv[8];
#pragma unroll
          for (int k = 0; k < 8; ++k) { const int i = tid + k * 512, t = i >> 5, c8 = (i & 31) * 8; vv[k] = *(const u32x4*)(a.proj + (tok0 + t) * 3072 + 1024 + h * 256 + c8); }
#pragma unroll
          for (int k = 0; k < 8; ++k) { const int i = tid + k * 512, t = i >> 5, c8 = (i & 31) * 8; *(u32x4*)(VTF + t * VSP + c8) = vv[k]; } }
        lds_barrier();
        f32x4 acc[2][8];
#pragma unroll
        for (int m = 0; m < 2; ++m)
#pragma unroll
            for (int n = 0; n < 8; ++n) acc[m][n] = (f32x4){0.f, 0.f, 0.f, 0.f};
#pragma unroll
        for (int ks = 0; ks < 4; ++ks) { bf16x8 af[2];
#pragma unroll
            for (int m = 0; m < 2; ++m) af[m] = tr_frag(VTF, VSP, ks * 32, wid * 32 + m * 16, lane);
#pragma unroll
            for (int n = 0; n < 8; ++n) { const bf16x8 bf = tr_frag_p(KT, LP, ks * 32, n, lane);
#pragma unroll
                for (int m = 0; m < 2; ++m) acc[m][n] = mfma16(bf, af[m], acc[m][n]); } }
        u16* st = a.states + (size_t)item * 256 * 128;
#pragma unroll
        for (int m = 0; m < 2; ++m)
#pragma unroll
            for (int n = 0; n < 8; n += 2) *(u32x4*)(st + (wid * 32 + m * 16 + fr) * 128 + n * 16 + fq * 8) = pk8(acc[m][n], acc[m][n + 1]);
        if (KIND == 0 && tid < 128) { float sum = 0.f; for (int t = 0; t < 128; ++t) sum += bf2f(KT[t * LP + tid]); a.dn[(size_t)item * 128 + tid] = sum; a.dec[(size_t)item * 128 + tid] = __expf(fB[127]); }
    }
}

DEVI void mix_scan_phase(const MixArgs a, bool with_n) {
    const int gt = obid() * 512 + otid(), nthr = gridDim.x * 512;
    for (int e = gt; e < 16 * 256 * 32; e += nthr) { const int dk4 = (e & 31) * 4, dv = (e >> 5) & 255, bh = e >> 13;
        f32x4 run = (f32x4){0.f, 0.f, 0.f, 0.f};
#pragma unroll 8
        for (int c = 0; c < NCH; ++c) { const size_t it = (size_t)bh * NCH + c; u16* sp = a.states + (it * 256 + dv) * 128 + dk4;
            const f32x4 d = *(const f32x4*)(a.dec + it * 128 + dk4); const bf16x4 x = *(const bf16x4*)sp;
            *(u32x2*)sp = pk4(run);
#pragma unroll
            for (int j = 0; j < 4; ++j) run[j] = d[j] * run[j] + bf2f((u16)x[j]); } }
    if (with_n) for (int e = gt; e < 16 * 128; e += nthr) { const int dk = e & 127, bh = e >> 7; float run = 0.f;
        for (int c = 0; c < NCH; ++c) { const size_t o = ((size_t)bh * NCH + c) * 128 + dk; const float x = a.dn[o], d = a.dec[o]; a.dn[o] = run; run = d * run + x; } }
}

template <int KIND>
DEVI void mix_out_phase(unsigned char* smem, const MixArgs a) {
    const int tid = otid(), wid = tid >> 6, lane = tid & 63, fr = lane & 15, fq = lane >> 4;
    float* fB = (float*)(smem + L_SM); float* fI = fB + 128; float* fN = fI + 128; float* seg = fN + 128; float* gl = (float*)(smem + L_SM + 4096);
    u16* QS = (u16*)(smem + L_QS); u16* KS = (u16*)(smem + L_KS); u16* SS = (u16*)(smem + L_SS); u16* VT = (u16*)(smem + L_VT); u16* CT = (u16*)(smem + L_CT);
    const int trow = wid * 16 + fr;
    for (int item = obid(); item < 16 * NCH; item += gridDim.x) {
        const int c = item % NCH, bh = item / NCH, h = bh & 3, b = bh >> 2; const size_t tok0 = (size_t)b * SEQ + c * CH;
        const size_t tok = tok0 + trow;
        bf16x8 gtv[8];
#pragma unroll
        for (int i = 0; i < 8; ++i) gtv[i] = *(const bf16x8*)(a.proj + tok * 3072 + 2048 + h * 256 + i * 32 + fq * 8);
        u32x4 pv[2][2], pc[2][2];
#define MIX_PREF(qq, bb) do { _Pragma("unroll") for (int k = 0; k < 2; ++k) { const int i = tid + k * 512; \
            pv[bb][k] = *(const u32x4*)(a.proj + (tok0 + (i >> 3)) * 3072 + 1024 + h * 256 + (qq) * 64 + (i & 7) * 8); \
            pc[bb][k] = *(const u32x4*)(a.states + ((size_t)item * 256 + (qq) * 64 + (i >> 4)) * 128 + (i & 15) * 8); } } while (0)
        MIX_PREF(0, 0); MIX_PREF(1, 1);
        lds_barrier();
        if (KIND == 0) { mlstm_gates(a, h, tok0, fB, fI); if (tid < 128) fN[tid] = a.dn[(size_t)item * 128 + tid];
#pragma unroll 4
            for (int i = tid; i < 128 * 32; i += 512) { const int t = (i >> 4) & 127, c8 = (i & 15) * 8, isk = i >> 11; float v[8];
                mlstm_conv8(a, tok0 + t, c * CH + t, isk * 512 + h * 128 + c8, v); const float sc = isk ? 1.f : 0.08838834764831845f;
                u32x4 w; w.x = cvt_pk(v[0] * sc, v[1] * sc); w.y = cvt_pk(v[2] * sc, v[3] * sc); w.z = cvt_pk(v[4] * sc, v[5] * sc); w.w = cvt_pk(v[6] * sc, v[7] * sc);
                *(u32x4*)((isk ? KS : QS) + t * LP + c8) = w; }
        } else {
#pragma unroll
            for (int k = 0; k < 4; ++k) { const int i = tid + k * 512; gl[i] = a.gates[(tok0 + (i >> 4)) * 16 + (i & 15)]; }
            { u32x4 qq[4], kk[4];
#pragma unroll
              for (int k = 0; k < 4; ++k) { const int i = tid + k * 512; const u16* pr = a.proj + (tok0 + (i >> 4)) * 3072 + h * 128 + (i & 15) * 8; qq[k] = *(const u32x4*)pr; kk[k] = *(const u32x4*)(pr + 512); }
#pragma unroll
              for (int k = 0; k < 4; ++k) { const int i = tid + k * 512; *(u32x4*)(QS + (i >> 4) * LP + (i & 15) * 8) = qq[k]; *(u32x4*)(KS + (i >> 4) * LP + (i & 15) * 8) = kk[k]; } }
            lds_barrier();
            const int ch = tid & 127, sg = tid >> 7; float w2r[16];
#pragma unroll
            for (int r = 0; r < 16; ++r) w2r[r] = a.w2[r * 512 + h * 128 + ch];
            const float gb = a.gateb[h * 128 + ch]; float ssum = 0.f;
            for (int t = sg * 32; t < sg * 32 + 32; ++t) ssum += gla_la(gl, t, w2r, gb);
            seg[sg * 128 + ch] = ssum; lds_barrier();
            float Bc = 0.f;
#pragma unroll
            for (int s2 = 0; s2 < 4; ++s2) { const float v = seg[s2 * 128 + ch]; if (s2 < sg) Bc += v; }
            for (int t = sg * 32; t < sg * 32 + 32; ++t) { Bc += gla_la(gl, t, w2r, gb);
                QS[t * LP + ch] = f2bf(bf2f(QS[t * LP + ch]) * 0.08838834764831845f * __expf(Bc)); KS[t * LP + ch] = f2bf(bf2f(KS[t * LP + ch]) * __expf(-Bc)); }
        }
        lds_barrier();
        bf16x8 qa[4];
#pragma unroll
        for (int ks = 0; ks < 4; ++ks) qa[ks] = *(const bf16x8*)(QS + trow * LP + ks * 32 + fq * 8);
        float rowsum = 0.f; const float bt = (KIND == 0) ? fB[trow] : 0.f;
        const int nmax = wid | 1;
        for (int n = 0; n <= nmax; ++n) { f32x4 s = (f32x4){0.f, 0.f, 0.f, 0.f};
            if (n <= wid) {
#pragma unroll
                for (int ks = 0; ks < 4; ++ks) { const bf16x8 kb = *(const bf16x8*)(KS + (n * 16 + fr) * LP + ks * 32 + fq * 8); s = mfma16(kb, qa[ks], s); }
#pragma unroll
                for (int j = 0; j < 4; ++j) { const int sc = n * 16 + fq * 4 + j;
                    if (sc <= trow) { if (KIND == 0) s[j] *= __expf(bt - fB[sc] + fI[sc]); } else s[j] = 0.f;
                    rowsum += s[j]; } }
            *(u32x2*)(SS + trow * LP + n * 16 + fq * 4) = pk4(s); }
        f32x4 o[16];
#pragma unroll
        for (int qv = 0; qv < 4; ++qv) {
            lds_barrier();
#pragma unroll
            for (int k = 0; k < 2; ++k) { const int i = tid + k * 512; *(u32x4*)(VT + (i >> 3) * VQP + (i & 7) * 8) = pv[qv & 1][k]; *(u32x4*)(CT + (i >> 4) * LP + (i & 15) * 8) = pc[qv & 1][k]; }
            lds_barrier();
            if (qv < 2) MIX_PREF(qv + 2, qv & 1);
#pragma unroll
            for (int n = 0; n < 4; ++n) { f32x4 ac = (f32x4){0.f, 0.f, 0.f, 0.f};
#pragma unroll
                for (int ks = 0; ks < 4; ++ks) { const bf16x8 cb = *(const bf16x8*)(CT + (32 * (n >> 1) + 8 * (fr >> 2) + 4 * (n & 1) + (fr & 3)) * LP + ks * 32 + fq * 8); ac = mfma16(cb, qa[ks], ac); }
                if (KIND == 0) ac = ac * __expf(bt);
                for (int ks = 0; ks <= (wid >> 1); ++ks) { const bf16x8 sa = *(const bf16x8*)(SS + trow * LP + ks * 32 + fq * 8); const bf16x8 vb = tr_frag_p(VT, VQP, ks * 32, n, lane); ac = mfma16(vb, sa, ac); }
                o[qv * 4 + n] = ac; }
        }
#undef MIX_PREF
        float scale = 1.f;
        if (KIND == 0) { float qn = 0.f;
#pragma unroll
            for (int i = 0; i < 32; ++i) qn += bf2f(QS[trow * LP + fq * 32 + i]) * fN[fq * 32 + i];
            qn += __shfl_xor(qn, 16); qn += __shfl_xor(qn, 32);
            rowsum += __shfl_xor(rowsum, 16); rowsum += __shfl_xor(rowsum, 32);
            const float den = rowsum + __expf(bt) * qn; scale = 1.f / fmaxf(fabsf(den), 1.f); }
        float ssq = 0.f;
#pragma unroll
        for (int i = 0; i < 16; ++i) { o[i] = o[i] * scale; ssq += o[i][0] * o[i][0] + o[i][1] * o[i][1] + o[i][2] * o[i][2] + o[i][3] * o[i][3]; }
        ssq += __shfl_xor(ssq, 16); ssq += __shfl_xor(ssq, 32);
        const float rs = rsqrtf(ssq * (1.f / 256.f) + 1e-6f);
#pragma unroll
        for (int pp = 0; pp < 8; ++pp) { const int col = h * 256 + pp * 32 + fq * 8; const f32x4 g0 = *(const f32x4*)(a.normg + col), g1 = *(const f32x4*)(a.normg + col + 4); f32x4 v0, v1;
#pragma unroll
            for (int j = 0; j < 4; ++j) { const float x0 = bf2f((u16)gtv[pp][j]), x1 = bf2f((u16)gtv[pp][4 + j]);
                v0[j] = o[2 * pp][j] * rs * g0[j] * (KIND == 0 ? sigmoidf_(x0) : siluf_(x0)); v1[j] = o[2 * pp + 1][j] * rs * g1[j] * (KIND == 0 ? sigmoidf_(x1) : siluf_(x1)); }
            *(u32x4*)(a.y + tok * DM + col) = pk8(v0, v1); }
    }
}

DEVI void s5_tables(const Params& p) {
    float* apow = (float*)(p.ws + OFF_APOW); float* bbo = (float*)(p.ws + OFF_BB);
    for (int e = obid() * 512 + otid(); e < 64 * 64; e += gridDim.x * 512) { const int g = e >> 6;
        const float lr = p.in[18][e], li = p.in[19][e]; const float dt = expf(p.in[20][g]);
        const double dlr = (double)lr * (double)dt, dli = (double)li * (double)dt;
        for (int tau = 0; tau < 34; ++tau) { const double mg = exp(dlr * tau), an = dli * tau; apow[((size_t)e * 34 + tau) * 2] = (float)(mg * cos(an)); apow[((size_t)e * 34 + tau) * 2 + 1] = (float)(mg * sin(an)); }
        const double are = exp(dlr) * cos(dli), aim = exp(dlr) * sin(dli), den = (double)lr * lr + (double)li * li;
        const double zre = ((are - 1.0) * lr + aim * li) / den, zim = (aim * lr - (are - 1.0) * li) / den;
        for (int hh = 0; hh < 16; ++hh) { const double br = p.in[21][(size_t)e * 16 + hh], bi = p.in[22][(size_t)e * 16 + hh];
            bbo[((size_t)e * 16 + hh) * 2] = (float)(zre * br - zim * bi); bbo[((size_t)e * 16 + hh) * 2 + 1] = (float)(zre * bi + zim * br); } }
}
DEVI void s5_kc(const Params& p) {
    const float* apow = (const float*)(p.ws + OFF_APOW); const float* bb = (const float*)(p.ws + OFF_BB); float* kc = (float*)(p.ws + OFF_KC);
    for (int e = obid() * 512 + otid(); e < 64 * 32 * 256; e += gridDim.x * 512) { const int h2 = e & 15, hh = (e >> 4) & 15, tau = (e >> 8) & 31, g = e >> 13; float s = 0.f;
        for (int pp = 0; pp < 64; ++pp) { const size_t gp = (size_t)g * 64 + pp; const float ar = apow[(gp * 34 + tau) * 2], ai = apow[(gp * 34 + tau) * 2 + 1];
            const float br = bb[(gp * 16 + h2) * 2], bi = bb[(gp * 16 + h2) * 2 + 1]; const float cr = p.in[23][((size_t)g * 16 + hh) * 64 + pp], ci = p.in[24][((size_t)g * 16 + hh) * 64 + pp];
            const float xr = ar * br - ai * bi, xi = ar * bi + ai * br; s += cr * xr - ci * xi; }
        kc[e] = s; }
}
DEVI void s5_fill(const Params& p) {
    const float* apow = (const float*)(p.ws + OFF_APOW); const float* bb = (const float*)(p.ws + OFF_BB); const float* kc = (const float*)(p.ws + OFF_KC);
    u16* bty = (u16*)(p.ws + OFF_BTY); u16* btg = (u16*)(p.ws + OFF_BTG);
    const int gt = obid() * 512 + otid(), nthr = gridDim.x * 512;
    for (int e = gt; e < 64 * 512 * 80; e += nthr) { const int k8 = (e % 80) * 8, n = (e / 80) & 511, g = e / (80 * 512), t = n >> 4, hh = n & 15; float v[8];
        if (k8 < 512) { const int s = k8 >> 4, h0 = k8 & 15;
#pragma unroll
            for (int j = 0; j < 8; ++j) { float x = 0.f; if (s <= t) { x = kc[(((size_t)g * 32 + (t - s)) * 16 + hh) * 16 + h0 + j]; if (s == t && h0 + j == hh) x += p.in[25][g * 16 + hh]; } v[j] = x; }
        } else { const int q0 = k8 - 512;
#pragma unroll
            for (int j = 0; j < 8; ++j) { const int q = q0 + j, pp = q & 63; const size_t gp = (size_t)g * 64 + pp; const float ar = apow[(gp * 34 + t + 1) * 2], ai = apow[(gp * 34 + t + 1) * 2 + 1];
                const float cr = p.in[23][((size_t)g * 16 + hh) * 64 + pp], ci = p.in[24][((size_t)g * 16 + hh) * 64 + pp]; v[j] = (q < 64) ? (cr * ar - ci * ai) : -(cr * ai + ci * ar); } }
        u32x4 w; w.x = cvt_pk(v[0], v[1]); w.y = cvt_pk(v[2], v[3]); w.z = cvt_pk(v[4], v[5]); w.w = cvt_pk(v[6], v[7]);
        *(u32x4*)(bty + ((size_t)g * 512 + n) * 640 + k8) = w; }
    for (int e = gt; e < 64 * 256 * 64; e += nthr) { const int k8 = (e & 63) * 8, n = (e >> 6) & 255, g = e >> 14, s = k8 >> 4, h0 = k8 & 15; float v[8];
#pragma unroll
        for (int j = 0; j < 8; ++j) { float x = 0.f; if (n < 128) { const int pp = n & 63; const size_t gp = (size_t)g * 64 + pp; const float ar = apow[(gp * 34 + 31 - s) * 2], ai = apow[(gp * 34 + 31 - s) * 2 + 1];
                const float br = bb[(gp * 16 + h0 + j) * 2], bi = bb[(gp * 16 + h0 + j) * 2 + 1]; x = (n < 64) ? (ar * br - ai * bi) : (ar * bi + ai * br); } v[j] = x; }
        u32x4 w; w.x = cvt_pk(v[0], v[1]); w.y = cvt_pk(v[2], v[3]); w.z = cvt_pk(v[4], v[5]); w.w = cvt_pk(v[6], v[7]);
        *(u32x4*)(btg + ((size_t)g * 256 + n) * 512 + k8) = w; }
}
DEVI void s5_scan(const Params& p) {
    const float* apow = (const float*)(p.ws + OFF_APOW); const float* send = (const float*)(p.ws + OFF_SEND); u16* ue = (u16*)(p.ws + OFF_UEXT);
    for (int e = obid() * 512 + otid(); e < 64 * 4 * 64; e += gridDim.x * 512) { const int pp = e & 63, b = (e >> 6) & 3, g = e >> 8;
        const float ar = apow[(((size_t)g * 64 + pp) * 34 + 32) * 2], ai = apow[(((size_t)g * 64 + pp) * 34 + 32) * 2 + 1]; float rr = 0.f, ri = 0.f;
#pragma unroll 8
        for (int c = 0; c < 256; ++c) { const size_t row = (size_t)g * 1024 + b * 256 + c; const float er = send[row * 128 + pp], ei = send[row * 128 + 64 + pp];
            ue[row * 640 + 512 + pp] = f2bf(rr); ue[row * 640 + 576 + pp] = f2bf(ri);
            const float nr = ar * rr - ai * ri + er, ni = ar * ri + ai * rr + ei; rr = nr; ri = ni; } }
}


#define XB_TMO      128
#define XB_XCNT(j)  (256  + 64 * (j))
#define XB_XSUB(j)  (1280 + 64 * (j))
#define XB_XGEN(j)  (2304 + 64 * (j))
#define XB_TOP      3328
#define XB_TOPGEN   3392
#define XCD_BAR_WORDS 3456
#define XB_SPIN_CAP (1u << 18)
DEVI unsigned xb_ld(unsigned* p)              { return __hip_atomic_load(p, __ATOMIC_RELAXED, __HIP_MEMORY_SCOPE_AGENT); }
DEVI unsigned xb_add(unsigned* p, unsigned v) { return __hip_atomic_fetch_add(p, v, __ATOMIC_RELAXED, __HIP_MEMORY_SCOPE_AGENT); }
DEVI unsigned xb_xcc_id() { return (unsigned)__builtin_amdgcn_s_getreg((3 << 11) | 20) & 0xFu; }
#define XB_SPIN(cond, bar) do { unsigned _sp = 0; while (cond) { __builtin_amdgcn_s_sleep(1); \
    if ((++_sp & 255u) == 0u) { if (xb_ld(&(bar)[XB_TMO])) break; if (_sp > XB_SPIN_CAP) { atomicAdd(&(bar)[XB_TMO], 1u); break; } } } } while (0)
struct XcdBarrier { unsigned* bar; unsigned x; volatile LAS unsigned* st; };
DEVI XcdBarrier xcd_barrier_post(unsigned* bar, volatile LAS unsigned* st) {
    XcdBarrier b; b.bar = bar; b.x = xb_xcc_id(); b.st = st;
    if (threadIdx.x == 0) (void)xb_add(&bar[XB_XCNT(b.x)], 1u);
    return b;
}
DEVI void xcd_barrier_complete(unsigned* bar, unsigned x, unsigned& nloc, unsigned& nx) {
    const unsigned G = gridDim.x * gridDim.y * gridDim.z;
    unsigned sum, cnt, mine, sp = 0u;
    for (;;) {
        sum = 0u; cnt = 0u; mine = 0u;
#pragma unroll
        for (unsigned j = 0; j < 16; ++j) { const unsigned c = xb_ld(&bar[XB_XCNT(j)]); sum += c; cnt += (c > 0u) ? 1u : 0u; mine = (j == x) ? c : mine; }
        if (sum == G) break;
        __builtin_amdgcn_s_sleep(1);
        if ((++sp & 255u) == 0u) { if (xb_ld(&bar[XB_TMO])) break; if (sp > XB_SPIN_CAP) { atomicAdd(&bar[XB_TMO], 1u); break; } }
    }
    nloc = mine > 0u ? mine : 1u; nx = cnt > 0u ? cnt : 1u;
}
DEVI void xcd_barrier(const XcdBarrier& b) {
    asm volatile("s_waitcnt vmcnt(0)" ::: "memory");
    __syncthreads();
    if (threadIdx.x == 0) {
        unsigned* bar = b.bar;
        __builtin_amdgcn_s_waitcnt(0);
        unsigned nloc = b.st[0], nx = b.st[1];
        if (nloc == 0u) { xcd_barrier_complete(bar, b.x, nloc, nx); b.st[0] = nloc; b.st[1] = nx; }
        const unsigned old = xb_add(&bar[XB_XSUB(b.x)], 1u);
        const unsigned gen = old / nloc;
        if (old + 1u == (gen + 1u) * nloc) {
            __builtin_amdgcn_fence(__ATOMIC_RELEASE, "agent");
            asm volatile("s_waitcnt vmcnt(0)" ::: "memory");
            const unsigned og = xb_add(&bar[XB_TOP], 1u);
            const unsigned tg = og / nx;
            if (og + 1u == (tg + 1u) * nx) xb_add(&bar[XB_TOPGEN], 1u);
            else XB_SPIN(xb_ld(&bar[XB_TOPGEN]) == tg, bar);
            __builtin_amdgcn_fence(__ATOMIC_ACQUIRE, "agent");
            xb_add(&bar[XB_XGEN(b.x)], 1u);
            asm volatile("s_waitcnt vmcnt(0)" ::: "memory");
        } else {
            XB_SPIN(xb_ld(&bar[XB_XGEN(b.x)]) == gen, bar);
            __builtin_amdgcn_fence(__ATOMIC_ACQUIRE, "agent");
            asm volatile("s_waitcnt vmcnt(0)" ::: "memory");
        }
    }
    __syncthreads();
}

__global__ void __launch_bounds__(512, 2) fwd_megakernel(Params p) {
    extern __shared__ __attribute__((aligned(16))) unsigned char smem[];
    cg::grid_group grid = cg::this_grid();
    LAS unsigned char* lds = (LAS unsigned char*)smem;
    unsigned char* ws = p.ws;
    u16* HN = (u16*)(ws + OFF_HN); u16* PROJ = (u16*)(ws + OFF_PROJ); float* GATES = (float*)(ws + OFF_GATES);
    float* H = p.out;
    unsigned* bar = (unsigned*)(ws + OFF_BAR);
    volatile LAS unsigned* st = (volatile LAS unsigned*)(lds + LDS_MAIN);
    if (blockIdx.x == 0) for (int i = threadIdx.x; i < XCD_BAR_WORDS; i += 512) bar[i] = 0u;
    if (threadIdx.x == 0) { st[0] = 0u; st[1] = 0u; }
    grid.sync();
    const XcdBarrier xb = xcd_barrier_post(bar, st);

    { int base = 0;
      for (int job = 0; job < 33; ++job) { const float* src; const float* gk; int K, N, Npad, mode; u16* dst; conv_job(p, job, src, K, N, dst, Npad, mode, gk);
        const int G = gridDim.x; int first = ((int)blockIdx.x - base) % G; if (first < 0) first += G;
        convT(src, K, N, dst, Npad, mode, gk, (float*)smem, first); base += (K / 64) * (Npad / 64); } }
    rms_phase(p.in[1], p.in[5], (u16*)(ws + OFF_MEMN), 1024);
    s5_tables(p);
    xcd_barrier(xb);
    { Gemm g{(const u16*)(ws + OFF_MEMN), (const u16*)(ws + OFF_W_XKV), 1024, 1024, 1024, 4, 8, 4, 0, 2048ull * 1024};
      gemm_phase(lds, g, EpiKV{(u16*)(ws + OFF_KBUF), (u16*)(ws + OFF_VT)}); }
    s5_kc(p);
    prep_phase(p.in[0], HN, (float*)(ws + OFF_SSQ));
    xcd_barrier(xb);

#pragma unroll 1
    for (int layer = 0; layer < 4; ++layer) {
        const int kind = layer % 3, j = layer / 3;
        const float* hin = layer == 0 ? p.in[0] : H;
        float* SSQ = (float*)(ws + OFF_SSQ) + (size_t)(3 * layer) * T_TOK * 4;
        if (kind != 2) {
            MixArgs a; a.proj = PROJ; a.gates = GATES; a.states = (u16*)(ws + OFF_STATES); a.dn = (float*)(ws + OFF_DN); a.dec = (float*)(ws + OFF_DEC); a.y = HN;
            const u16* wout;
            if (kind == 0) { a.convw = p.in[8] + j * 4096; a.gateb = p.in[9] + j * 8; a.w2 = nullptr; a.normg = p.in[10] + j * 1024; wout = (const u16*)(ws + OFF_W_AOUT + j * SZ_SQ);
                Gemm g{HN, (const u16*)(ws + OFF_W_AIN + j * SZ_AIN), 1024, 1024, 1024, 128, 13, 1, 0, 0}; gemm_phase(lds, g, EpiInProj{PROJ, GATES, 8, SSQ}); }
            else { a.convw = nullptr; a.gateb = p.in[14]; a.w2 = p.in[13]; a.normg = p.in[15]; wout = (const u16*)(ws + OFF_W_BOUT);
                Gemm g{HN, (const u16*)(ws + OFF_W_BIN), 1024, 1024, 1024, 128, 13, 1, 0, 0}; gemm_phase(lds, g, EpiInProj{PROJ, GATES, 16, SSQ}); }
            xcd_barrier(xb);
            if (kind == 0) mix_state_phase<0>(smem, a); else mix_state_phase<1>(smem, a);
            xcd_barrier(xb);
            mix_scan_phase(a, kind == 0);
            {
                Gemm g1{(const u16*)(ws + OFF_KBUF + layer * SZ_SQ), (const u16*)(ws + OFF_W_XQ + layer * SZ_SQ), 1024, 1024, 256, 1, 4, 16, 262144, 0}; g1.split = 1; g1.sA_lo = 256; g1.sB_lo = 256;
                gemm_phase(lds, g1, EpiG{(u16*)(ws + OFF_GBT)});
                Gemm g2{(const u16*)(ws + OFF_W_XO + layer * SZ_SQ), (const u16*)(ws + OFF_VT + layer * SZ_SQ), 1024, 1024, 256, 4, 1, 16, 0, 262144}; g2.split = 1; g2.sA_lo = 256; g2.sB_lo = 256;
                gemm_phase(lds, g2, EpiVW{(u16*)(ws + OFF_VWBT)});
            }
            xcd_barrier(xb);
            if (kind == 0) mix_out_phase<0>(smem, a); else mix_out_phase<1>(smem, a);
            xcd_barrier(xb);
            { Gemm g{HN, wout, 1024, 1024, 1024, 128, 4, 1, 0, 0}; gemm_phase(lds, g, EpiResid{hin, H, (u16*)(ws + OFF_HB), SSQ + 4 * T_TOK}); }
        } else {
            { Gemm g{HN, (const u16*)(ws + OFF_W_CIN), 1024, 1024, 1024, 128, 4, 1, 0, 0}; gemm_phase(lds, g, EpiUext{(u16*)(ws + OFF_UEXT), SSQ}); }
            s5_fill(p);
            xcd_barrier(xb);
            { Gemm g{(const u16*)(ws + OFF_UEXT), (const u16*)(ws + OFF_BTG), 640, 512, 512, 4, 1, 64, 1024ull * 640, 256ull * 512}; gemm_phase(lds, g, EpiSend{(float*)(ws + OFF_SEND)}); }
            xcd_barrier(xb);
            s5_scan(p);
            {
                Gemm g1{(const u16*)(ws + OFF_KBUF + layer * SZ_SQ), (const u16*)(ws + OFF_W_XQ + layer * SZ_SQ), 1024, 1024, 256, 1, 4, 16, 262144, 0}; g1.split = 1; g1.sA_lo = 256; g1.sB_lo = 256;
                gemm_phase(lds, g1, EpiG{(u16*)(ws + OFF_GBT)});
                Gemm g2{(const u16*)(ws + OFF_W_XO + layer * SZ_SQ), (const u16*)(ws + OFF_VT + layer * SZ_SQ), 1024, 1024, 256, 4, 1, 16, 0, 262144}; g2.split = 1; g2.sA_lo = 256; g2.sB_lo = 256;
                gemm_phase(lds, g2, EpiVW{(u16*)(ws + OFF_VWBT)});
            }
            xcd_barrier(xb);
            { Gemm g{(const u16*)(ws + OFF_UEXT), (const u16*)(ws + OFF_BTY), 640, 640, 640, 4, 2, 64, 1024ull * 640, 512ull * 640}; gemm_phase(lds, g, EpiS5Y{HN}); }
            xcd_barrier(xb);
            { Gemm g{HN, (const u16*)(ws + OFF_W_CGATE), 1024, 1024, 1024, 128, 4, 1, 0, 0}; gemm_phase(lds, g, EpiS5Gate{HN, p.in[27], (u16*)(ws + OFF_Z)}); }
            xcd_barrier(xb);
            { Gemm g{(const u16*)(ws + OFF_Z), (const u16*)(ws + OFF_W_COUT), 1024, 1024, 1024, 128, 4, 1, 0, 0}; gemm_phase(lds, g, EpiResid{hin, H, (u16*)(ws + OFF_HB), SSQ + 4 * T_TOK}); }
        }
        xcd_barrier(xb);
        { Gemm g{(const u16*)(ws + OFF_HB), (const u16*)(ws + OFF_GBT), 1024, 1024, 1024, 128, 4, 1, 0, 0}; g.pmsh = 5; g.sBpm = 1024ull * 1024;
          gemm_phase(lds, g, EpiSoftmax{(u16*)(ws + OFF_XO), SSQ + 4 * T_TOK}); }
        xcd_barrier(xb);
        { Gemm g{(const u16*)(ws + OFF_XO), (const u16*)(ws + OFF_VWBT), 1024, 1024, 1024, 128, 4, 1, 0, 0}; g.pmsh = 5; g.sBpm = 1024ull * 1024;
          gemm_phase(lds, g, EpiResid{H, H, HN, SSQ + 8 * T_TOK}); }
        xcd_barrier(xb);
        { Gemm g{HN, (const u16*)(ws + OFF_W_FGU + layer * SZ_FGU), 1024, 1024, 1024, 128, 22, 1, 0, 0}; gemm_phase(lds, g, EpiSwiglu{PROJ, SSQ + 8 * T_TOK}); }
        xcd_barrier(xb);
        { Gemm g{PROJ, (const u16*)(ws + OFF_W_FD + layer * SZ_FD), 2816, 2816, 2816, 128, 4, 1, 0, 0}; gemm_phase(lds, g, EpiResid{H, H, HN, SSQ + 12 * T_TOK}); }
        xcd_barrier(xb);
    }
    rms_final(H, p.in[6]);
}

extern "C" void kernel_launch(void* const* d_in, const int* in_sizes, int n_in, void* d_out, int out_size, void* d_ws, size_t ws_size, hipStream_t stream) {
    static int grid_blocks = 0;
    if (grid_blocks == 0) {
        if (n_in != 35 || ws_size < WS_END) { fprintf(stderr, "kernel_launch: unexpected n_in %d or ws_size %zu (need %zu)\n", n_in, ws_size, (size_t)WS_END); grid_blocks = -1; return; }
        int dev = 0, cus = 0, per_cu = 0;
        hipGetDevice(&dev);
        hipDeviceGetAttribute(&cus, hipDeviceAttributeMultiprocessorCount, dev);
        hipFuncSetAttribute((const void*)fwd_megakernel, hipFuncAttributeMaxDynamicSharedMemorySize, LDS_BYTES);
        hipOccupancyMaxActiveBlocksPerMultiprocessor(&per_cu, (const void*)fwd_megakernel, 512, LDS_BYTES);
        if (per_cu < 1) per_cu = 1;
        grid_blocks = cus * per_cu;
    }
    if (grid_blocks < 0) return;
    Params p{};
    for (int i = 0; i < 35; ++i) p.in[i] = (const float*)d_in[i];
    p.out = (float*)d_out; p.ws = (unsigned char*)d_ws;
    void* args[] = {&p};
    hipError_t e = hipLaunchCooperativeKernel((const void*)fwd_megakernel, dim3(grid_blocks), dim3(512), args, LDS_BYTES, stream);
    if (e != hipSuccess) fprintf(stderr, "cooperative launch failed: %s (grid %d)\n", hipGetErrorString(e), grid_blocks);
}
```

```cpp
#include <hip/hip_runtime.h>
#include <hip/hip_cooperative_groups.h>
#include <cstdio>
namespace cg = cooperative_groups;

typedef unsigned short u16;
typedef short bf16x8 __attribute__((ext_vector_type(8))) __attribute__((may_alias));
typedef short bf16x4 __attribute__((ext_vector_type(4))) __attribute__((may_alias));
typedef float f32x4 __attribute__((ext_vector_type(4))) __attribute__((may_alias));
typedef unsigned u32x4 __attribute__((ext_vector_type(4))) __attribute__((may_alias));
typedef unsigned u32x2 __attribute__((ext_vector_type(2))) __attribute__((may_alias));
#define LAS __attribute__((address_space(3)))
#define DEVI __device__ __forceinline__

constexpr int T_TOK = 32768, DM = 1024, SEQ = 8192;
constexpr int LDS_MAIN = 155648;
constexpr int LDS_BYTES = LDS_MAIN + 16;
constexpr int CH = 128;
constexpr int NCH = SEQ / CH;
constexpr int LP = 136;

constexpr size_t MiB = 1ull << 20;
constexpr size_t SZ_AIN = 3328ull * 1024 * 2, SZ_SQ = 1024ull * 1024 * 2, SZ_FGU = 5632ull * 1024 * 2, SZ_FD = 1024ull * 2816 * 2;
constexpr size_t OFF_W_AIN = 0;
constexpr size_t OFF_W_AOUT = OFF_W_AIN + 2 * SZ_AIN;
constexpr size_t OFF_W_BIN = OFF_W_AOUT + 2 * SZ_SQ;
constexpr size_t OFF_W_BOUT = OFF_W_BIN + SZ_AIN;
constexpr size_t OFF_W_CIN = OFF_W_BOUT + SZ_SQ;
constexpr size_t OFF_W_CGATE = OFF_W_CIN + SZ_SQ;
constexpr size_t OFF_W_COUT = OFF_W_CGATE + SZ_SQ;
constexpr size_t OFF_W_XQ = OFF_W_COUT + SZ_SQ;
constexpr size_t OFF_W_XKV = OFF_W_XQ + 4 * SZ_SQ;
constexpr size_t OFF_W_XO = OFF_W_XKV + 8 * SZ_SQ;
constexpr size_t OFF_W_FGU = OFF_W_XO + 4 * SZ_SQ;
constexpr size_t OFF_W_FD = OFF_W_FGU + 4 * SZ_FGU;
constexpr size_t OFF_MEMN = OFF_W_FD + 4 * SZ_FD;
constexpr size_t OFF_KBUF = OFF_MEMN + SZ_SQ;
constexpr size_t OFF_VT = OFF_KBUF + 4 * SZ_SQ;
constexpr size_t OFF_HN = OFF_VT + 4 * SZ_SQ;
constexpr size_t OFF_PROJ = OFF_HN + 64 * MiB;
constexpr size_t OFF_STATES = OFF_PROJ + 192 * MiB;
constexpr size_t OFF_GATES = OFF_STATES + 64 * MiB;
constexpr size_t OFF_DN = OFF_GATES + 2 * MiB;
constexpr size_t OFF_DEC = OFF_DN + MiB / 2;
constexpr size_t OFF_KC = OFF_DEC + MiB / 2;
constexpr size_t OFF_APOW = OFF_KC + 2 * MiB;
constexpr size_t OFF_BB = OFF_APOW + 5 * MiB / 4;
constexpr size_t OFF_BAR = OFF_BB + MiB / 2;
constexpr size_t OFF_SSQ = OFF_BAR + 16384;
constexpr size_t OFF_GBT = OFF_SSQ + 13ull * 32768 * 16;
constexpr size_t OFF_VWBT = OFF_GBT + 8 * MiB;
constexpr size_t WS_END = OFF_VWBT + 8 * MiB;
constexpr size_t OFF_UEXT = OFF_PROJ, OFF_SEND = OFF_PROJ + 80 * MiB, OFF_Z = OFF_PROJ + 112 * MiB;
constexpr size_t OFF_HB = OFF_PROJ, OFF_XO = OFF_PROJ + 64 * MiB, OFF_XQ = OFF_PROJ + 128 * MiB;
constexpr size_t OFF_BTY = OFF_STATES, OFF_BTG = OFF_STATES + 40 * MiB;

struct Params { const float* in[35]; float* out; unsigned char* ws; };

DEVI int otid() { int t = threadIdx.x; asm volatile("" : "+v"(t)); return t; }
DEVI int obid() { int t = blockIdx.x; asm volatile("" : "+s"(t)); return t; }
DEVI unsigned char* oput(unsigned char* q) { asm volatile("" : "+s"(q)); return q; }
DEVI float bf2f(u16 b) { return __uint_as_float(((unsigned)b) << 16); }
typedef __bf16 bf16v2_t __attribute__((ext_vector_type(2)));
typedef float f32v2_t __attribute__((ext_vector_type(2)));
DEVI unsigned cvt_pk(float lo, float hi) { f32v2_t f = {lo, hi}; bf16v2_t v = __builtin_convertvector(f, bf16v2_t); return __builtin_bit_cast(unsigned, v); }
DEVI u16 f2bf(float f) { return (u16)(cvt_pk(f, 0.f) & 0xffffu); }
DEVI u32x2 pk4(f32x4 v) { u32x2 r; r.x = cvt_pk(v[0], v[1]); r.y = cvt_pk(v[2], v[3]); return r; }
DEVI float sigmoidf_(float x) { return __builtin_amdgcn_rcpf(1.f + __expf(-x)); }
DEVI float siluf_(float x) { return x * __builtin_amdgcn_rcpf(1.f + __expf(-x)); }
DEVI float logsigf_(float x) { return fminf(x, 0.f) - __logf(1.f + __expf(-fabsf(x))); }
DEVI float gelu_tanh(float x) { const float u = 0.7978845608028654f * (x + 0.044715f * x * x * x); return x * sigmoidf_(2.f * u); }
DEVI void lds_barrier() { asm volatile("s_waitcnt lgkmcnt(0)\n\ts_barrier" ::: "memory"); }
DEVI f32x4 mfma16(bf16x8 a, bf16x8 b, f32x4 c) { return __builtin_amdgcn_mfma_f32_16x16x32_bf16(a, b, c, 0, 0, 0); }

constexpr int BM = 256, BK = 64, HALF = 128, HTB = HALF * BK * 2, NXCD = 8, WGM = 8;
DEVI int lds_byte(int r, int c) { const int st = (r >> 4) * 2 + (c >> 5), rr = r & 15, cc = c & 31, ob = rr * 64 + cc * 2; return st * 1024 + (ob ^ (((ob >> 9) & 1) << 5)); }
DEVI void stage_rc(int b, int& R, int& C) { const int st = b / 1024, sb = b % 1024, swz = sb ^ (((sb >> 9) & 1) << 5); R = (st >> 1) * 16 + swz / 64; C = (st & 1) * 32 + (swz % 64) / 2; }

DEVI int perm32(int rho) { const int n = rho >> 4, i = rho & 15; return 8 * (i >> 2) + 4 * n + (i & 3); }
struct Unit { int pm, pn, b; };
struct Gemm { const u16* A; const u16* Bt; int lda, ldb, K, nM, nN, nB; size_t sA, sB;
    int split = 0; size_t sA_lo = 0, sB_lo = 0;
    int pmsh = 31; size_t sBpm = 0; };
DEVI size_t gemm_offA(const Gemm& g, const Unit& u) { return g.split ? (size_t)(u.b >> 2) * g.sA + (size_t)(u.b & 3) * g.sA_lo : (size_t)u.b * g.sA; }
DEVI size_t gemm_offB(const Gemm& g, const Unit& u) { return (g.split ? (size_t)(u.b >> 2) * g.sB + (size_t)(u.b & 3) * g.sB_lo : (size_t)u.b * g.sB) + (size_t)(u.pm >> g.pmsh) * g.sBpm; }

DEVI bool unit_next(const Gemm& g, int i, Unit& u) {
    const int nwg = g.nM * g.nN; const long L = (long)i * gridDim.x + obid();
    if (L >= (long)nwg * g.nB) return false;
    u.b = (int)(L / nwg); int wgid = (int)(L % nwg);
    { const int q = nwg / NXCD, r = nwg % NXCD, xcd = wgid % NXCD, off = wgid / NXCD; wgid = (xcd < r ? xcd * (q + 1) : r * (q + 1) + (xcd - r) * q) + off; }
    const int nig = WGM * g.nN, gid = wgid / nig, fm = gid * WGM, gsz = (g.nM - fm) < WGM ? (g.nM - fm) : WGM;
    u.pm = fm + ((wgid % nig) % gsz); u.pn = (wgid % nig) / gsz; return true;
}

DEVI u32x4 pk8(f32x4 a, f32x4 b);
template <class Epi>
DEVI void gemm_phase(LAS unsigned char* lds, const Gemm g, const Epi& E) {
    const int tid = otid(), wid = __builtin_amdgcn_readfirstlane(tid >> 6), lane = tid & 63, wr = wid >> 2, wc = wid & 3, fr = lane & 15, fq = lane >> 4;
    const int nt = g.K / BK;
    unsigned voffA[2], voffB[2];
#pragma unroll
    for (int i = 0; i < 2; ++i) { int R, C; stage_rc(tid * 16 + i * 8192, R, C); voffA[i] = (unsigned)(R * g.lda + C) * 2u; const int Rb = Epi::PERM ? ((R & ~31) + perm32(R & 31)) : R; voffB[i] = (unsigned)(Rb * g.ldb + C) * 2u; }
    const size_t kstep = (size_t)(BK * 2);
    const size_t hstepA = (size_t)HALF * g.lda * 2, hstepB = (size_t)HALF * g.ldb * 2;
    const size_t tstepA = 2 * hstepA, tstepB = 2 * hstepB;
    const unsigned ldsw = (unsigned)wid * 1024u;
    const int aoff = lds_byte(wr * 64 + fr, fq * 8), boff = lds_byte(wc * 32 + fr, fq * 8);
#define PG8_SA(b, h) (((b) * 2 + (h)) * HTB)
#define PG8_SB(b, h) ((4 + (b) * 2 + (h)) * HTB)
#define PG8_STAGE(bufoff, gbase, voff) do { _Pragma("unroll") for (int _i = 0; _i < 2; ++_i) \
        __builtin_amdgcn_global_load_lds((const unsigned*)((const char*)(gbase) + (voff)[_i]), (LAS unsigned*)(lds + (bufoff) + ldsw + _i * 8192), 16, 0, 0); } while (0)
#define PG8_LDA(dst, b, h) do { _Pragma("unroll") for (int m = 0; m < 4; ++m) _Pragma("unroll") for (int k = 0; k < 2; ++k) dst[m][k] = *(const LAS bf16x8*)(lds + PG8_SA(b, h) + aoff + m * 2048 + k * 1024); } while (0)
#define PG8_LDB(dst, b, h) do { _Pragma("unroll") for (int n = 0; n < 2; ++n) _Pragma("unroll") for (int k = 0; k < 2; ++k) dst[n][k] = *(const LAS bf16x8*)(lds + PG8_SB(b, h) + boff + n * 2048 + k * 1024); } while (0)
#define PG8_MMA(ai, bj, At, Bt) do { __builtin_amdgcn_s_setprio(1); _Pragma("unroll") for (int m = 0; m < 4; ++m) _Pragma("unroll") for (int n = 0; n < 2; ++n) _Pragma("unroll") for (int k = 0; k < 2; ++k) \
        acc[ai][bj][m][n] = __builtin_amdgcn_mfma_f32_16x16x32_bf16(Bt[n][k], At[m][k], acc[ai][bj][m][n], 0, 0, 0); __builtin_amdgcn_s_setprio(0); } while (0)
#define PG8_WAIT_V(n) asm volatile("s_waitcnt vmcnt(" #n ")" ::: "memory")
#define PG8_WAIT_L(n) asm volatile("s_waitcnt lgkmcnt(" #n ")" ::: "memory")
#define PG8_BAR __builtin_amdgcn_s_barrier()
#define PG8_SCHED __builtin_amdgcn_sched_barrier(0)
    Unit cur, nxt; int ui = 0;
    if (!unit_next(g, 0, cur)) return;
    f32x4 acc[2][2][4][2];
#pragma unroll
    for (int a = 0; a < 2; ++a)
#pragma unroll
        for (int b = 0; b < 2; ++b)
#pragma unroll
            for (int m = 0; m < 4; ++m)
#pragma unroll
                for (int n = 0; n < 2; ++n) acc[a][b][m][n] = (f32x4){0.f, 0.f, 0.f, 0.f};
    bf16x8 At[4][2], B0[2][2], B1[2][2];
    const char* cA = (const char*)g.A + gemm_offA(g, cur) * 2 + (size_t)cur.pm * tstepA;
    const char* cB = (const char*)g.Bt + gemm_offB(g, cur) * 2 + (size_t)cur.pn * tstepB;
    PG8_STAGE(PG8_SB(0, 0), cB, voffB); PG8_STAGE(PG8_SA(0, 0), cA, voffA); PG8_STAGE(PG8_SB(0, 1), cB + hstepB, voffB); PG8_STAGE(PG8_SA(0, 1), cA + hstepA, voffA);
    if (wr == 1) PG8_BAR;
    PG8_WAIT_V(4); PG8_BAR;
    PG8_STAGE(PG8_SB(1, 0), cB + kstep, voffB); PG8_STAGE(PG8_SA(1, 0), cA + kstep, voffA); PG8_STAGE(PG8_SB(1, 1), cB + hstepB + kstep, voffB);
    PG8_WAIT_V(6); PG8_BAR;
    for (;;) {
        const bool has_next = unit_next(g, ui + 1, nxt);
        const char* nA = has_next ? (const char*)g.A + gemm_offA(g, nxt) * 2 + (size_t)nxt.pm * tstepA : cA;
        const char* nB = has_next ? (const char*)g.Bt + gemm_offB(g, nxt) * 2 + (size_t)nxt.pn * tstepB : cB;
        for (int t = 0; t < nt; t += 2) {
            const bool last = (t == nt - 2);
            const char* a1 = cA + (size_t)(t + 1) * kstep;
            const char* a2 = last ? nA : cA + (size_t)(t + 2) * kstep; const char* b2 = last ? nB : cB + (size_t)(t + 2) * kstep;
            const char* a3 = a2 + kstep; const char* b3 = b2 + kstep;
            PG8_LDB(B0, 0, 0); PG8_SCHED; PG8_LDA(At, 0, 0); PG8_STAGE(PG8_SA(1, 1), a1 + hstepA, voffA);
            PG8_WAIT_L(8); PG8_BAR; PG8_WAIT_L(0); PG8_MMA(0, 0, At, B0); PG8_BAR; PG8_SCHED;
            PG8_LDB(B1, 0, 1); PG8_STAGE(PG8_SB(0, 0), b2, voffB);
            PG8_BAR; PG8_WAIT_L(0); PG8_MMA(0, 1, At, B1); PG8_BAR;
            PG8_LDA(At, 0, 1); PG8_STAGE(PG8_SA(0, 0), a2, voffA);
            PG8_BAR; PG8_WAIT_L(0); PG8_MMA(1, 0, At, B0); PG8_BAR; PG8_SCHED;
            PG8_STAGE(PG8_SB(0, 1), b2 + hstepB, voffB);
            PG8_WAIT_V(6); PG8_BAR; PG8_MMA(1, 1, At, B1); PG8_BAR;
            PG8_LDB(B0, 1, 0); PG8_SCHED; PG8_LDA(At, 1, 0); PG8_STAGE(PG8_SA(0, 1), a2 + hstepA, voffA);
            PG8_WAIT_L(8); PG8_BAR; PG8_WAIT_L(0); PG8_MMA(0, 0, At, B0); PG8_BAR; PG8_SCHED;
            PG8_LDB(B1, 1, 1); PG8_STAGE(PG8_SB(1, 0), b3, voffB);
            PG8_BAR; PG8_WAIT_L(0); PG8_MMA(0, 1, At, B1); PG8_BAR;
            PG8_LDA(At, 1, 1); PG8_STAGE(PG8_SA(1, 0), a3, voffA);
            PG8_BAR; PG8_WAIT_L(0); PG8_MMA(1, 0, At, B0); PG8_BAR; PG8_SCHED;
            PG8_STAGE(PG8_SB(1, 1), b3 + hstepB, voffB);
            PG8_WAIT_V(6); PG8_BAR; PG8_MMA(1, 1, At, B1); PG8_BAR;
        }
        {
            const int row0 = cur.pm * BM + wr * 64 + fr, col0 = cur.pn * BM + wc * 32 + (Epi::PERM ? 8 : 4) * fq; constexpr int NST = Epi::PERM ? 4 : 16;
            float rsv[8];
            if constexpr (Epi::RS) { f32x4 q4[8];
#pragma unroll
                for (int i = 0; i < 8; ++i) q4[i] = *(const f32x4*)(E.ssq_in + (size_t)(row0 + (i >> 2) * HALF + (i & 3) * 16) * 4);
#pragma unroll
                for (int i = 0; i < 8; ++i) rsv[i] = rsqrtf((((q4[i][0] + q4[i][1]) + q4[i][2]) + q4[i][3]) * (1.f / DM) + 1e-6f); }
            if constexpr (Epi::SOFTMAX) {
                LAS float* red = (LAS float*)(lds + 131072);
#pragma unroll
                for (int ai = 0; ai < 2; ++ai)
#pragma unroll
                    for (int m = 0; m < 4; ++m) { const float sc = rsv[ai * 4 + m] * 0.0625f; float part = 0.f;
#pragma unroll
                        for (int bj = 0; bj < 2; ++bj)
#pragma unroll
                            for (int n = 0; n < 2; ++n)
#pragma unroll
                                for (int j = 0; j < 4; ++j) { const float e = __expf(fmaxf(fminf(acc[ai][bj][m][n][j] * sc, 80.f), -80.f)); acc[ai][bj][m][n][j] = e; part += e; }
                        part += __shfl_xor(part, 16); part += __shfl_xor(part, 32);
                        if (fq == 0) red[(wr * 4 + wc) * 128 + ai * 64 + m * 16 + fr] = part; }
                PG8_WAIT_L(0); PG8_BAR;
#pragma unroll
                for (int ai = 0; ai < 2; ++ai)
#pragma unroll
                    for (int m = 0; m < 4; ++m) { const LAS float* rr = red + wr * 512 + ai * 64 + m * 16 + fr;
                        const float inv = __builtin_amdgcn_rcpf(((rr[0] + rr[128]) + rr[256]) + rr[384]); const int r = row0 + ai * HALF + m * 16;
#pragma unroll
                        for (int bj = 0; bj < 2; ++bj) *(u32x4*)(E.P + (size_t)r * DM + col0 + bj * HALF) = pk8(acc[ai][bj][m][0] * inv, acc[ai][bj][m][1] * inv); }
            } else
#pragma unroll
            for (int am = 0; am < 4; ++am) {
                const int ai = am >> 1, m0 = (am & 1) * 2;
                f32x4 pre[2][2][2];
                if constexpr (Epi::PRE) {
#pragma unroll
                    for (int m = 0; m < 2; ++m)
#pragma unroll
                        for (int bj = 0; bj < 2; ++bj)
#pragma unroll
                            for (int n = 0; n < 2; ++n) pre[m][bj][n] = E.load(row0 + ai * HALF + (m0 + m) * 16, col0 + bj * HALF + n * NST);
                }
#pragma unroll
                for (int mm = 0; mm < 2; ++mm) {
                    const int m = m0 + mm;
                    const int r = row0 + ai * HALF + m * 16; float rs = 1.f, part = 0.f;
                    if constexpr (Epi::RS) rs = rsv[ai * 4 + m];
                    if constexpr (Epi::PAIR) E.pair8(cur.b, r, cur.pn * HALF + wc * 32 + 8 * fq, acc[ai][0][m][0] * rs, acc[ai][0][m][1] * rs, acc[ai][1][m][0] * rs, acc[ai][1][m][1] * rs);
                    else
#pragma unroll
                    for (int bj = 0; bj < 2; ++bj) {
                        const int c = col0 + bj * HALF; f32x4 v0 = acc[ai][bj][m][0], v1 = acc[ai][bj][m][1];
                        if constexpr (Epi::RS) { v0 = v0 * rs; v1 = v1 * rs; }
                        if constexpr (Epi::PRE) part += E.frag_pre8(cur.b, r, c, v0, v1, pre[mm][bj][0], pre[mm][bj][1]);
                        else if constexpr (Epi::PERM) E.frag8(cur.b, r, c, v0, v1);
                        else { E.frag(cur.b, r, c, v0); E.frag(cur.b, r, c + 16, v1); }
                    }
                    if constexpr (Epi::SSQ) { part += __shfl_xor(part, 16); part += __shfl_xor(part, 32); if (fq == 0) ((LAS float*)(lds + 131072))[(wr * 4 + wc) * 128 + ai * 64 + m * 16 + fr] = part; }
                }
            }
            if constexpr (Epi::SSQ) {
                PG8_WAIT_L(0); PG8_BAR;
                if (lane < 32) { const int rl = wc * 32 + lane; const LAS float* red = (const LAS float*)(lds + 131072) + wr * 512 + rl;
                    const float sum = ((red[0] + red[128]) + red[256]) + red[384];
                    E.ssq_out[(size_t)(cur.pm * BM + (rl >> 6) * HALF + wr * 64 + (rl & 63)) * 4 + cur.pn] = sum; }
            }
        }
        if (!has_next) break;
#pragma unroll
        for (int a = 0; a < 2; ++a)
#pragma unroll
            for (int b = 0; b < 2; ++b)
#pragma unroll
                for (int m = 0; m < 4; ++m)
#pragma unroll
                    for (int n = 0; n < 2; ++n) acc[a][b][m][n] = (f32x4){0.f, 0.f, 0.f, 0.f};
        cur = nxt; cA = nA; cB = nB; ++ui;
    }
    PG8_WAIT_V(0);
    if (wr == 0) PG8_BAR;
    PG8_BAR;
#undef PG8_SA
#undef PG8_SB
#undef PG8_STAGE
#undef PG8_LDA
#undef PG8_LDB
#undef PG8_MMA
#undef PG8_WAIT_V
#undef PG8_WAIT_L
#undef PG8_BAR
#undef PG8_SCHED
}

DEVI u32x4 pk8(f32x4 a, f32x4 b) { u32x4 w; w.x = cvt_pk(a[0], a[1]); w.y = cvt_pk(a[2], a[3]); w.z = cvt_pk(b[0], b[1]); w.w = cvt_pk(b[2], b[3]); return w; }
struct EpiBf16 { static constexpr bool PAIR = false, RS = true, SSQ = false, PRE = false, PERM = true, SOFTMAX = false; u16* O; int ldc; const float* ssq_in;
    DEVI void frag8(int, int r, int c, f32x4 v0, f32x4 v1) const { *(u32x4*)(O + (size_t)r * ldc + c) = pk8(v0, v1); } };
struct EpiInProj { static constexpr bool PAIR = false, RS = true, SSQ = false, PRE = false, PERM = true, SOFTMAX = false; u16* O; float* gates; int ngate; const float* ssq_in;
    DEVI void frag8(int, int r, int c, f32x4 v0, f32x4 v1) const {
        if (c < 3072) *(u32x4*)(O + (size_t)r * 3072 + c) = pk8(v0, v1);
        else if (c - 3072 < ngate) { float* gp = gates + (size_t)r * 16 + (c - 3072); *(f32x4*)gp = v0; *(f32x4*)(gp + 4) = v1; } } };
struct EpiResid { static constexpr bool PAIR = false, RS = false, SSQ = true, PRE = true, PERM = true, SOFTMAX = false; const float* hin; float* hout; u16* hb; float* ssq_out;
    DEVI f32x4 load(int r, int c) const { return *(const f32x4*)(hin + (size_t)r * DM + c); }
    DEVI float frag_pre8(int, int r, int c, f32x4 v0, f32x4 v1, f32x4 p0, f32x4 p1) const { const size_t o = (size_t)r * DM + c; const f32x4 h0 = p0 + v0, h1 = p1 + v1;
        *(f32x4*)(hout + o) = h0; *(f32x4*)(hout + o + 4) = h1; *(u32x4*)(hb + o) = pk8(h0, h1);
        return ((h0[0] * h0[0] + h0[1] * h0[1]) + (h0[2] * h0[2] + h0[3] * h0[3])) + ((h1[0] * h1[0] + h1[1] * h1[1]) + (h1[2] * h1[2] + h1[3] * h1[3])); } };
struct EpiSwiglu { static constexpr bool PAIR = true, RS = true, SSQ = false, PRE = false, PERM = true, SOFTMAX = false; u16* O; const float* ssq_in;
    DEVI void pair8(int, int r, int c, f32x4 g0, f32x4 g1, f32x4 u0, f32x4 u1) const { f32x4 a, b;
#pragma unroll
        for (int j = 0; j < 4; ++j) { a[j] = siluf_(g0[j]) * u0[j]; b[j] = siluf_(g1[j]) * u1[j]; }
        *(u32x4*)(O + (size_t)r * 2816 + c) = pk8(a, b); } };
struct EpiKV { static constexpr bool PAIR = false, RS = false, SSQ = false, PRE = false, PERM = true, SOFTMAX = false; u16* kbuf; u16* vbuf;
    DEVI void frag8(int l, int r, int c, f32x4 v0, f32x4 v1) const { u16* base = c < 1024 ? kbuf : vbuf; *(u32x4*)(base + (size_t)l * 1024 * 1024 + (size_t)r * 1024 + (c & 1023)) = pk8(v0, v1); } };
struct EpiG { static constexpr bool PAIR = false, RS = false, SSQ = false, PRE = false, PERM = true, SOFTMAX = false; u16* G;
    DEVI void frag8(int bh, int r, int c, f32x4 v0, f32x4 v1) const { *(u32x4*)(G + ((size_t)(bh >> 2) * 1024 + (bh & 3) * 256 + r) * 1024 + c) = pk8(v0, v1); } };
struct EpiVW { static constexpr bool PAIR = false, RS = false, SSQ = false, PRE = false, PERM = true, SOFTMAX = false; u16* VW;
    DEVI void frag8(int bh, int r, int c, f32x4 v0, f32x4 v1) const { *(u32x4*)(VW + ((size_t)(bh >> 2) * 1024 + r) * 1024 + (bh & 3) * 256 + c) = pk8(v0, v1); } };
struct EpiSoftmax { static constexpr bool PAIR = false, RS = true, SSQ = false, PRE = false, PERM = true, SOFTMAX = true; u16* P; const float* ssq_in; };
struct EpiUext { static constexpr bool PAIR = false, RS = true, SSQ = false, PRE = false, PERM = true, SOFTMAX = false; u16* U; const float* ssq_in;
    DEVI void frag8(int, int r, int c, f32x4 v0, f32x4 v1) const { *(u32x4*)(U + ((size_t)(c >> 4) * 1024 + (r >> 5)) * 640 + (r & 31) * 16 + (c & 15)) = pk8(v0, v1); } };
struct EpiSend { static constexpr bool PAIR = false, RS = false, SSQ = false, PRE = false, PERM = false, SOFTMAX = false; float* S;
    DEVI void frag(int g, int r, int c, f32x4 v) const { if (c < 128) *(f32x4*)(S + ((size_t)g * 1024 + r) * 128 + c) = v; } };
struct EpiS5Y { static constexpr bool PAIR = false, RS = false, SSQ = false, PRE = false, PERM = true, SOFTMAX = false; u16* Y;
    DEVI void frag8(int g, int r, int c, f32x4 v0, f32x4 v1) const { f32x4 o0, o1;
#pragma unroll
        for (int j = 0; j < 4; ++j) { o0[j] = gelu_tanh(v0[j]); o1[j] = gelu_tanh(v1[j]); }
        *(u32x4*)(Y + ((size_t)r * 32 + (c >> 4)) * DM + g * 16 + (c & 15)) = pk8(o0, o1); } };
struct EpiS5Gate { static constexpr bool PAIR = false, RS = false, SSQ = false, PRE = true, PERM = true, SOFTMAX = false; const u16* Y; const float* bg; u16* Z;
    DEVI f32x4 load(int r, int c) const { const bf16x4 y = *(const bf16x4*)(Y + (size_t)r * DM + c); return (f32x4){bf2f((u16)y[0]), bf2f((u16)y[1]), bf2f((u16)y[2]), bf2f((u16)y[3])}; }
    DEVI float frag_pre8(int, int r, int c, f32x4 v0, f32x4 v1, f32x4 y0, f32x4 y1) const { const f32x4 b0 = *(const f32x4*)(bg + c), b1 = *(const f32x4*)(bg + c + 4); f32x4 z0, z1;
#pragma unroll
        for (int j = 0; j < 4; ++j) { z0[j] = y0[j] * sigmoidf_(v0[j] + b0[j]); z1[j] = y1[j] * sigmoidf_(v1[j] + b1[j]); }
        *(u32x4*)(Z + (size_t)r * DM + c) = pk8(z0, z1); return 0.f; } };

DEVI void convT(const float* src, int K, int N, u16* dst, int Npad, int mode, const float* gk, float* tile, int first) {
    const int tid = otid(), ntk = K / 64, ntn = Npad / 64;
    for (int ti = first; ti < ntk * ntn; ti += gridDim.x) {
        const int k0 = (ti % ntk) * 64, n0 = (ti / ntk) * 64;
        for (int i = tid; i < 1024; i += 512) { const int kk = i >> 4, n4 = (i & 15) * 4, n = n0 + n4;
            f32x4 v = (f32x4){0.f, 0.f, 0.f, 0.f}; if (n < N) { v = *(const f32x4*)(src + (size_t)(k0 + kk) * N + n); if (gk) v = v * gk[k0 + kk]; }
            float* tp = tile + kk * 65 + n4; tp[0] = v[0]; tp[1] = v[1]; tp[2] = v[2]; tp[3] = v[3]; }
        __syncthreads();
        if (mode == 3) { const int kk = tid >> 3, n8 = (tid & 7) * 8; const float* tp = tile + kk * 65 + n8;
          u32x4 w; w.x = cvt_pk(tp[0], tp[1]); w.y = cvt_pk(tp[2], tp[3]); w.z = cvt_pk(tp[4], tp[5]); w.w = cvt_pk(tp[6], tp[7]);
          *(u32x4*)(dst + (size_t)(k0 + kk) * N + n0 + n8) = w; }
        else { const int nn = tid >> 3, k8 = (tid & 7) * 8; const int n = n0 + nn;
          int row = n; if (mode == 1) row = 256 * (n >> 7) + (n & 127); else if (mode == 2) row = 256 * (n >> 7) + 128 + (n & 127);
          u32x4 w; w.x = cvt_pk(tile[(k8 + 0) * 65 + nn], tile[(k8 + 1) * 65 + nn]); w.y = cvt_pk(tile[(k8 + 2) * 65 + nn], tile[(k8 + 3) * 65 + nn]);
          w.z = cvt_pk(tile[(k8 + 4) * 65 + nn], tile[(k8 + 5) * 65 + nn]); w.w = cvt_pk(tile[(k8 + 6) * 65 + nn], tile[(k8 + 7) * 65 + nn]);
          *(u32x4*)(dst + (size_t)row * K + k0 + k8) = w; }
        __syncthreads();
    }
}
DEVI void conv_job(const Params& p, int job, const float*& src, int& K, int& N, u16*& dst, int& Npad, int& mode, const float*& gk) {
    unsigned char* ws = p.ws; K = 1024; N = 1024; Npad = 1024; mode = 0; gk = nullptr;
    if (job < 2) { src = p.in[7] + (size_t)job * 1024 * 3080; N = 3080; Npad = 3328; dst = (u16*)(ws + OFF_W_AIN + job * SZ_AIN); gk = p.in[2] + 3 * job * DM; }
    else if (job < 4) { src = p.in[11] + (size_t)(job - 2) * 1024 * 1024; dst = (u16*)(ws + OFF_W_AOUT + (job - 2) * SZ_SQ); }
    else if (job == 4) { src = p.in[12]; N = 3088; Npad = 3328; dst = (u16*)(ws + OFF_W_BIN); gk = p.in[2] + 1 * DM; }
    else if (job == 5) { src = p.in[16]; dst = (u16*)(ws + OFF_W_BOUT); }
    else if (job == 6) { src = p.in[17]; dst = (u16*)(ws + OFF_W_CIN); gk = p.in[2] + 2 * DM; }
    else if (job == 7) { src = p.in[26]; dst = (u16*)(ws + OFF_W_CGATE); }
    else if (job == 8) { src = p.in[28]; dst = (u16*)(ws + OFF_W_COUT); }
    else if (job < 13) { const int i = job - 9; src = p.in[29] + (size_t)i * 1024 * 1024; dst = (u16*)(ws + OFF_W_XQ + i * SZ_SQ); gk = p.in[3] + i * DM; mode = 3; }
    else if (job < 17) { const int i = job - 13; src = p.in[30] + (size_t)i * 1024 * 2048; N = 2048; Npad = 2048; dst = (u16*)(ws + OFF_W_XKV + i * 2 * SZ_SQ); }
    else if (job < 21) { const int i = job - 17; src = p.in[31] + (size_t)i * 1024 * 1024; dst = (u16*)(ws + OFF_W_XO + i * SZ_SQ); }
    else if (job < 25) { const int i = job - 21; src = p.in[32] + (size_t)i * 1024 * 2816; N = 2816; Npad = 2816; mode = 1; dst = (u16*)(ws + OFF_W_FGU + i * SZ_FGU); gk = p.in[4] + i * DM; }
    else if (job < 29) { const int i = job - 25; src = p.in[33] + (size_t)i * 1024 * 2816; N = 2816; Npad = 2816; mode = 2; dst = (u16*)(ws + OFF_W_FGU + i * SZ_FGU); gk = p.in[4] + i * DM; }
    else { const int i = job - 29; src = p.in[34] + (size_t)i * 2816 * 1024; K = 2816; dst = (u16*)(ws + OFF_W_FD + i * SZ_FD); }
}

DEVI void rms_phase(const float* src, const float* g, u16* dst, int rows) {
    const int lane = otid() & 63, gw = obid() * 8 + (otid() >> 6), nw = gridDim.x * 8;
    f32x4 gv[4];
#pragma unroll
    for (int i = 0; i < 4; ++i) gv[i] = *(const f32x4*)(g + i * 256 + lane * 4);
    for (int r = gw; r < rows; r += nw) {
        const float* s = src + (size_t)r * DM; f32x4 v[4]; float ss = 0.f;
#pragma unroll
        for (int i = 0; i < 4; ++i) { v[i] = *(const f32x4*)(s + i * 256 + lane * 4); ss += v[i][0] * v[i][0] + v[i][1] * v[i][1] + v[i][2] * v[i][2] + v[i][3] * v[i][3]; }
#pragma unroll
        for (int o = 32; o > 0; o >>= 1) ss += __shfl_xor(ss, o);
        const float rs = rsqrtf(ss * (1.f / DM) + 1e-6f);
#pragma unroll
        for (int i = 0; i < 4; ++i) *(u32x2*)(dst + (size_t)r * DM + i * 256 + lane * 4) = pk4(v[i] * rs * gv[i]);
    }
}
DEVI void prep_phase(const float* src, u16* dst, float* ssq) {
    const int lane = otid() & 63, gw = obid() * 8 + (otid() >> 6), nw = gridDim.x * 8;
    for (int r = gw; r < T_TOK; r += nw) {
        const float* s = src + (size_t)r * DM; f32x4 v[4]; float ss = 0.f;
#pragma unroll
        for (int i = 0; i < 4; ++i) { v[i] = *(const f32x4*)(s + i * 256 + lane * 4); ss += v[i][0] * v[i][0] + v[i][1] * v[i][1] + v[i][2] * v[i][2] + v[i][3] * v[i][3]; }
#pragma unroll
        for (int o = 32; o > 0; o >>= 1) ss += __shfl_xor(ss, o);
#pragma unroll
        for (int i = 0; i < 4; ++i) *(u32x2*)(dst + (size_t)r * DM + i * 256 + lane * 4) = pk4(v[i]);
        if (lane == 0) *(f32x4*)(ssq + (size_t)r * 4) = (f32x4){ss, 0.f, 0.f, 0.f};
    }
}
DEVI void rms_final(float* io, const float* g) {
    const int lane = otid() & 63, gw = obid() * 8 + (otid() >> 6), nw = gridDim.x * 8;
    f32x4 gv[4];
#pragma unroll
    for (int i = 0; i < 4; ++i) gv[i] = *(const f32x4*)(g + i * 256 + lane * 4);
    for (int r = gw; r < T_TOK; r += nw) {
        float* s = io + (size_t)r * DM; f32x4 v[4]; float ss = 0.f;
#pragma unroll
        for (int i = 0; i < 4; ++i) { v[i] = *(const f32x4*)(s + i * 256 + lane * 4); ss += v[i][0] * v[i][0] + v[i][1] * v[i][1] + v[i][2] * v[i][2] + v[i][3] * v[i][3]; }
#pragma unroll
        for (int o = 32; o > 0; o >>= 1) ss += __shfl_xor(ss, o);
        const float rs = rsqrtf(ss * (1.f / DM) + 1e-6f);
#pragma unroll
        for (int i = 0; i < 4; ++i) *(f32x4*)(s + i * 256 + lane * 4) = v[i] * rs * gv[i];
    }
}

constexpr int KVP = 264;
DEVI void attn_stage(u16* img, const u16* src, int rstride, int tid) {
#pragma unroll
    for (int it = 0; it < 2; ++it) { u32x4 v[8];
#pragma unroll
        for (int k = 0; k < 8; ++k) { const int i = tid + (it * 8 + k) * 512, r = i >> 5, c8 = (i & 31) * 8; v[k] = *(const u32x4*)(src + (size_t)r * rstride + c8); }
#pragma unroll
        for (int k = 0; k < 8; ++k) { const int i = tid + (it * 8 + k) * 512, r = i >> 5, c8 = (i & 31) * 8; *(u32x4*)(img + r * KVP + c8) = v[k]; } }
}
DEVI void attn_phase(unsigned char* smem, const u16* Q, const u16* Kb, const u16* Vt, u16* O) {
    const int tid = otid(), wid = tid >> 6, lane = tid & 63, fr = lane & 15, fq = lane >> 4;
    u16* img = (u16*)smem;
    for (int item = obid(); item < 1024; item += gridDim.x) {
        const int qb = item & 63, bh = item >> 6, h = bh & 3, b = bh >> 2;
        lds_barrier();
        attn_stage(img, Kb + (size_t)(b * 256) * DM + h * 256, DM, tid);
        lds_barrier();
        bf16x8 pb[1][8]; float inv[1];
#pragma unroll
        for (int rb = 0; rb < 1; ++rb) {
            const size_t qrow = (size_t)b * SEQ + qb * 128 + rb * 128 + wid * 16 + fr;
            const u16* q = Q + qrow * DM + h * 256 + fq * 8;
            bf16x8 qf[8];
#pragma unroll
            for (int ks = 0; ks < 8; ++ks) qf[ks] = *(const bf16x8*)(q + ks * 32);
            f32x4 s[16];
#pragma unroll
            for (int kt = 0; kt < 16; ++kt) { s[kt] = (f32x4){0.f, 0.f, 0.f, 0.f};
#pragma unroll
                for (int ks = 0; ks < 8; ++ks) { const bf16x8 a = *(const bf16x8*)(img + (kt * 16 + fr) * KVP + ks * 32 + fq * 8); s[kt] = mfma16(a, qf[ks], s[kt]); } }
            float mx = -3.0e38f;
#pragma unroll
            for (int kt = 0; kt < 16; ++kt)
#pragma unroll
                for (int j = 0; j < 4; ++j) mx = fmaxf(mx, s[kt][j]);
            mx = fmaxf(mx, __shfl_xor(mx, 16)); mx = fmaxf(mx, __shfl_xor(mx, 32));
            const float sc = 0.0625f * 1.4426950408889634f; float sum = 0.f;
#pragma unroll
            for (int kt = 0; kt < 16; ++kt)
#pragma unroll
                for (int j = 0; j < 4; ++j) { const float e = __builtin_amdgcn_exp2f((s[kt][j] - mx) * sc); s[kt][j] = e; sum += e; }
            sum += __shfl_xor(sum, 16); sum += __shfl_xor(sum, 32);
            inv[rb] = 1.f / sum;
#pragma unroll
            for (int ks = 0; ks < 8; ++ks) { u32x4 w; w.x = cvt_pk(s[2 * ks][0], s[2 * ks][1]); w.y = cvt_pk(s[2 * ks][2], s[2 * ks][3]); w.z = cvt_pk(s[2 * ks + 1][0], s[2 * ks + 1][1]); w.w = cvt_pk(s[2 * ks + 1][2], s[2 * ks + 1][3]);
                pb[rb][ks] = __builtin_bit_cast(bf16x8, w); }
        }
        lds_barrier();
        attn_stage(img, Vt + (size_t)(b * 4 + h) * 256 * 256, 256, tid);
        lds_barrier();
#pragma unroll
        for (int rb = 0; rb < 1; ++rb) {
            const size_t qrow = (size_t)b * SEQ + qb * 128 + rb * 128 + wid * 16 + fr;
            u16* orow = O + qrow * DM + h * 256 + fq * 8;
            const int prow = 8 * (fr >> 2) + (fr & 3);
#pragma unroll
            for (int dp = 0; dp < 8; ++dp) { f32x4 o0 = (f32x4){0.f, 0.f, 0.f, 0.f}, o1 = o0;
#pragma unroll
                for (int ks = 0; ks < 8; ++ks) { const u16* vp = img + (dp * 32 + prow) * KVP + ks * 32 + fq * 4;
                    { const u32x2 lo = *(const u32x2*)(vp), hi = *(const u32x2*)(vp + 16); u32x4 w; w.x = lo.x; w.y = lo.y; w.z = hi.x; w.w = hi.y; o0 = mfma16(__builtin_bit_cast(bf16x8, w), pb[rb][ks], o0); }
                    { const u32x2 lo = *(const u32x2*)(vp + 4 * KVP), hi = *(const u32x2*)(vp + 4 * KVP + 16); u32x4 w; w.x = lo.x; w.y = lo.y; w.z = hi.x; w.w = hi.y; o1 = mfma16(__builtin_bit_cast(bf16x8, w), pb[rb][ks], o1); } }
                *(u32x4*)(orow + dp * 32) = pk8(o0 * inv[rb], o1 * inv[rb]); }
        }
    }
}

constexpr int L_SM = 0;
constexpr int VQP = 68;
constexpr int L_QS = 16384, L_KS = L_QS + 128 * LP * 2, L_SS = L_KS + 128 * LP * 2, L_VT = L_SS + 128 * LP * 2, L_CT = L_VT + 64 * LP * 2;
constexpr int VSP = 264;
constexpr int L_VTF = 16384, L_KT = 86016;

struct MixArgs { const u16* proj; const float* gates; const float* convw; const float* gateb; const float* w2; const float* normg; u16* states; float* dn; float* dec; u16* y; };

DEVI void mlstm_gates(const MixArgs& a, int h, size_t tok0, float* fB, float* fI) {
    const int tid = otid();
    if (tid < 128) { const float* g = a.gates + (tok0 + tid) * 16; fI[tid] = g[h] + a.gateb[h]; fB[tid] = logsigf_(g[4 + h] + a.gateb[4 + h]); }
    lds_barrier();
    if (tid < 64) { float x0 = fB[2 * tid], x1 = fB[2 * tid + 1]; float s = x0 + x1;
#pragma unroll
        for (int o = 1; o < 64; o <<= 1) { const float t = __shfl_up(s, o); if (tid >= o) s += t; }
        fB[2 * tid] = s - x1; fB[2 * tid + 1] = s; }
    lds_barrier();
}
DEVI void mlstm_conv8(const MixArgs& a, size_t tok, int pos, int ch0, float* out) {
    float accv[8];
#pragma unroll
    for (int i = 0; i < 8; ++i) accv[i] = 0.f;
#pragma unroll
    for (int j = 0; j < 4; ++j) { if (pos - 3 + j >= 0) { const bf16x8 x = *(const bf16x8*)(a.proj + (tok - 3 + j) * 3072 + ch0);
            const f32x4 w0 = *(const f32x4*)(a.convw + j * 1024 + ch0), w1 = *(const f32x4*)(a.convw + j * 1024 + ch0 + 4);
#pragma unroll
            for (int i = 0; i < 4; ++i) { accv[i] += w0[i] * bf2f((u16)x[i]); accv[4 + i] += w1[i] * bf2f((u16)x[4 + i]); } } }
#pragma unroll
    for (int i = 0; i < 8; ++i) out[i] = siluf_(accv[i]);
}
DEVI float gla_la(const float* gl, int t, const float* w2r, float gb) { float x = gb;
#pragma unroll
    for (int r = 0; r < 16; ++r) x += gl[t * 16 + r] * w2r[r];
    return logsigf_(x) * (1.f / 16.f); }

typedef short s4v_t __attribute__((ext_vector_type(4)));
DEVI bf16x8 tr_frag(const u16* img, int RS, int r0, int c0, int lane) {
    const u16* a = img + (r0 + (lane >> 4) * 8 + ((lane & 15) >> 2)) * RS + c0 + 4 * (lane & 3);
    const s4v_t lo = __builtin_amdgcn_ds_read_tr16_b64_v4i16((LAS s4v_t*)a);
    const s4v_t hi = __builtin_amdgcn_ds_read_tr16_b64_v4i16((LAS s4v_t*)(a + 4 * RS));
    bf16x8 r; r[0] = lo[0]; r[1] = lo[1]; r[2] = lo[2]; r[3] = lo[3]; r[4] = hi[0]; r[5] = hi[1]; r[6] = hi[2]; r[7] = hi[3]; return r;
}
DEVI bf16x8 tr_frag_p(const u16* img, int RS, int r0, int n, int lane) {
    const u16* a = img + (r0 + (lane >> 4) * 8 + ((lane & 15) >> 2)) * RS + 32 * (n >> 1) + 8 * (lane & 3) + 4 * (n & 1);
    const s4v_t lo = __builtin_amdgcn_ds_read_tr16_b64_v4i16((LAS s4v_t*)a);
    const s4v_t hi = __builtin_amdgcn_ds_read_tr16_b64_v4i16((LAS s4v_t*)(a + 4 * RS));
    bf16x8 r; r[0] = lo[0]; r[1] = lo[1]; r[2] = lo[2]; r[3] = lo[3]; r[4] = hi[0]; r[5] = hi[1]; r[6] = hi[2]; r[7] = hi[3]; return r;
}

constexpr int L_RAWK = L_KT + 128 * LP * 2;
DEVI void mlstm_conv8_lds(const u16* raw, const float* convw, int t, int c8, int ch0, float* out) {
    float accv[8];
#pragma unroll
    for (int i = 0; i < 8; ++i) accv[i] = 0.f;
#pragma unroll
    for (int j = 0; j < 4; ++j) { const bf16x8 x = *(const bf16x8*)(raw + (t + j) * 128 + c8);
        const f32x4 w0 = *(const f32x4*)(convw + j * 1024 + ch0), w1 = *(const f32x4*)(convw + j * 1024 + ch0 + 4);
#pragma unroll
        for (int i = 0; i < 4; ++i) { accv[i] += w0[i] * bf2f((u16)x[i]); accv[4 + i] += w1[i] * bf2f((u16)x[4 + i]); } }
#pragma unroll
    for (int i = 0; i < 8; ++i) out[i] = siluf_(accv[i]);
}

template <int KIND>
DEVI void mix_state_phase(unsigned char* smem, const MixArgs a) {
    const int tid = otid(), wid = tid >> 6, lane = tid & 63, fr = lane & 15, fq = lane >> 4;
    float* fB = (float*)(smem + L_SM); float* fI = fB + 128; float* seg = fI + 256; float* gl = (float*)(smem + L_SM + 4096);
    u16* VTF = (u16*)(smem + L_VTF); u16* KT = (u16*)(smem + L_KT); u16* RAWK = (u16*)(smem + L_RAWK);
    u32x4 pvv[8], pkr[5]; float pg[4];
#define ST_PREF(it_) do { const int c_ = (it_) % NCH, bh_ = (it_) / NCH, h_ = bh_ & 3, b_ = bh_ >> 2; const size_t t0_ = (size_t)b_ * SEQ + c_ * CH; \
        _Pragma("unroll") for (int k = 0; k < 8; ++k) { const int i = tid + k * 512; pvv[k] = *(const u32x4*)(a.proj + (t0_ + (i >> 5)) * 3072 + 1024 + h_ * 256 + (i & 31) * 8); } \
        if (KIND == 0) { _Pragma("unroll") for (int k = 0; k < 5; ++k) { const int q = tid + k * 512, rr = q >> 4; pkr[k] = (u32x4){0u, 0u, 0u, 0u}; \
                if (q < 131 * 16 && !(c_ == 0 && rr < 3)) pkr[k] = *(const u32x4*)(a.proj + (t0_ + rr - 3) * 3072 + 512 + h_ * 128 + (q & 15) * 8); } \
            if (tid < 128) { const float* g_ = a.gates + (t0_ + tid) * 16; pg[0] = g_[h_]; pg[1] = g_[4 + h_]; } } \
        else { _Pragma("unroll") for (int k = 0; k < 4; ++k) { const int i = tid + k * 512; pkr[k] = *(const u32x4*)(a.proj + (t0_ + (i >> 4)) * 3072 + 512 + h_ * 128 + (i & 15) * 8); pg[k] = a.gates[(t0_ + (i >> 4)) * 16 + (i & 15)]; } } } while (0)
    if (obid() < 16 * NCH) ST_PREF(obid());
    for (int item = obid(); item < 16 * NCH; item += gridDim.x) {
        const int c = item % NCH, bh = item / NCH, h = bh & 3;
        lds_barrier();
#pragma unroll
        for (int k = 0; k < 8; ++k) { const int i = tid + k * 512, t = i >> 5, c8 = (i & 31) * 8; *(u32x4*)(VTF + t * VSP + c8) = pvv[k]; }
        if (KIND == 0) {
#pragma unroll
            for (int k = 0; k < 5; ++k) { const int q = tid + k * 512; if (q < 131 * 16) *(u32x4*)(RAWK + (q >> 4) * 128 + (q & 15) * 8) = pkr[k]; }
            if (tid < 128) { fI[tid] = pg[0] + a.gateb[h]; fB[tid] = logsigf_(pg[1] + a.gateb[4 + h]); }
        } else {
#pragma unroll
            for (int k = 0; k < 4; ++k) { const int i = tid + k * 512; *(u32x4*)(KT + (i >> 4) * LP + (i & 15) * 8) = pkr[k]; gl[i] = pg[k]; }
        }
        lds_barrier();
        if (item + (int)gridDim.x < 16 * NCH) ST_PREF(item + (int)gridDim.x);
        (void)c;
        if (KIND == 0) {
            if (tid < 64) { float x0 = fB[2 * tid], x1 = fB[2 * tid + 1]; float sc = x0 + x1;
#pragma unroll
                for (int o = 1; o < 64; o <<= 1) { const float t = __shfl_up(sc, o); if (tid >= o) sc += t; }
                fB[2 * tid] = sc - x1; fB[2 * tid + 1] = sc; }
            lds_barrier();
            const float bl = fB[127];
#pragma unroll 2
            for (int i = tid; i < 128 * 16; i += 512) { const int t = i >> 4, c8 = (i & 15) * 8; float v[8]; mlstm_conv8_lds(RAWK, a.convw, t, c8, 512 + h * 128 + c8, v); const float w = __expf(bl - fB[t] + fI[t]);
                u32x4 pw; pw.x = cvt_pk(v[0] * w, v[1] * w); pw.y = cvt_pk(v[2] * w, v[3] * w); pw.z = cvt_pk(v[4] * w, v[5] * w); pw.w = cvt_pk(v[6] * w, v[7] * w);
                *(u32x4*)(KT + t * LP + c8) = pw; }
        } else {
            const int ch = tid & 127, sg = tid >> 7; float w2r[16];
#pragma unroll
            for (int r = 0; r < 16; ++r) w2r[r] = a.w2[r * 512 + h * 128 + ch];
            const float gb = a.gateb[h * 128 + ch]; float ssum = 0.f;
            for (int t = sg * 32; t < sg * 32 + 32; ++t) ssum += gla_la(gl, t, w2r, gb);
            seg[sg * 128 + ch] = ssum; lds_barrier();
            float Bc = 0.f, tot = 0.f;
#pragma unroll
            for (int s2 = 0; s2 < 4; ++s2) { const float v = seg[s2 * 128 + ch]; tot += v; if (s2 < sg) Bc += v; }
            for (int t = sg * 32; t < sg * 32 + 32; ++t) { Bc += gla_la(gl, t, w2r, gb);
                const float kv = bf2f(KT[t * LP + ch]); KT[t * LP + ch] = f2bf(kv * __expf(tot - Bc)); }
            if (sg == 0) a.dec[(size_t)item * 128 + ch] = __expf(tot);
        }
        lds_barrier();
        f32x4 acc[2][8];
#pragma unroll
        for (int m = 0; m < 2; ++m)
#pragma unroll
            for (int n = 0; n < 8; ++n) acc[m][n] = (f32x4){0.f, 0.f, 0.f, 0.f};
#pragma unroll
        for (int ks = 0; ks < 4; ++ks) { bf16x8 af[2];
#pragma unroll
            for (int m = 0; m < 2; ++m) af[m] = tr_frag(VTF, VSP, ks * 32, wid * 32 + m * 16, lane);
#pragma unroll
            for (int n = 0; n < 8; ++n) { const bf16x8 bf = tr_frag_p(KT, LP, ks * 32, n, lane);
#pragma unroll
                for (int m = 0; m < 2; ++m) acc[m][n] = mfma16(bf, af[m], acc[m][n]); } }
        u16* st = a.states + (size_t)item * 256 * 128;
#pragma unroll
        for (int m = 0; m < 2; ++m)
#pragma unroll
            for (int n = 0; n < 8; n += 2) *(u32x4*)(st + (wid * 32 + m * 16 + fr) * 128 + n * 16 + fq * 8) = pk8(acc[m][n], acc[m][n + 1]);
        if (KIND == 0 && tid < 128) { float sum = 0.f; for (int t = 0; t < 128; ++t) sum += bf2f(KT[t * LP + tid]); a.dn[(size_t)item * 128 + tid] = sum; a.dec[(size_t)item * 128 + tid] = __expf(fB[127]); }
    }
#undef ST_PREF
}

DEVI void mix_scan_phase(const MixArgs a, bool with_n) {
    const int gt = obid() * 512 + otid(), nthr = gridDim.x * 512;
    for (int e = gt; e < 16 * 256 * 32; e += nthr) { const int dk4 = (e & 31) * 4, dv = (e >> 5) & 255, bh = e >> 13;
        f32x4 run = (f32x4){0.f, 0.f, 0.f, 0.f};
#pragma unroll 8
        for (int c = 0; c < NCH; ++c) { const size_t it = (size_t)bh * NCH + c; u16* sp = a.states + (it * 256 + dv) * 128 + dk4;
            const f32x4 d = *(const f32x4*)(a.dec + it * 128 + dk4); const bf16x4 x = *(const bf16x4*)sp;
            *(u32x2*)sp = pk4(run);
#pragma unroll
            for (int j = 0; j < 4; ++j) run[j] = d[j] * run[j] + bf2f((u16)x[j]); } }
    if (with_n) for (int e = gt; e < 16 * 128; e += nthr) { const int dk = e & 127, bh = e >> 7; float run = 0.f;
        for (int c = 0; c < NCH; ++c) { const size_t o = ((size_t)bh * NCH + c) * 128 + dk; const float x = a.dn[o], d = a.dec[o]; a.dn[o] = run; run = d * run + x; } }
}

template <int KIND>
DEVI void mix_out_phase(unsigned char* smem, const MixArgs a) {
    const int tid = otid(), wid = tid >> 6, lane = tid & 63, fr = lane & 15, fq = lane >> 4;
    float* fB = (float*)(smem + L_SM); float* fI = fB + 128; float* fN = fI + 128; float* seg = fN + 128; float* gl = (float*)(smem + L_SM + 4096);
    u16* QS = (u16*)(smem + L_QS); u16* KS = (u16*)(smem + L_KS); u16* SS = (u16*)(smem + L_SS); u16* VT = (u16*)(smem + L_VT); u16* CT = (u16*)(smem + L_CT);
    u16* RAW = (u16*)(smem + L_SS);
    const int trow = wid * 16 + fr;
    u32x4 prq[9]; float pg[4];
#define OUT_PREF(it_) do { const int c_ = (it_) % NCH, bh_ = (it_) / NCH, h_ = bh_ & 3, b_ = bh_ >> 2; const size_t t0_ = (size_t)b_ * SEQ + c_ * CH; \
        if (KIND == 0) { _Pragma("unroll") for (int k = 0; k < 9; ++k) { const int q = tid + k * 512, rr = q >> 5; prq[k] = (u32x4){0u, 0u, 0u, 0u}; \
                if (q < 131 * 32 && !(c_ == 0 && rr < 3)) prq[k] = *(const u32x4*)(a.proj + (t0_ + rr - 3) * 3072 + ((q >> 4) & 1) * 512 + h_ * 128 + (q & 15) * 8); } \
            if (tid < 128) { const float* g_ = a.gates + (t0_ + tid) * 16; pg[0] = g_[h_]; pg[1] = g_[4 + h_]; pg[2] = a.dn[(size_t)(it_) * 128 + tid]; } } \
        else { _Pragma("unroll") for (int k = 0; k < 4; ++k) { const int i = tid + k * 512; const u16* pr_ = a.proj + (t0_ + (i >> 4)) * 3072 + h_ * 128 + (i & 15) * 8; \
                prq[k] = *(const u32x4*)pr_; prq[4 + k] = *(const u32x4*)(pr_ + 512); pg[k] = a.gates[(t0_ + (i >> 4)) * 16 + (i & 15)]; } } } while (0)
    if (KIND == 1 && obid() < 16 * NCH) OUT_PREF(obid());
    for (int item = obid(); item < 16 * NCH; item += gridDim.x) {
        const int c = item % NCH, bh = item / NCH, h = bh & 3, b = bh >> 2; const size_t tok0 = (size_t)b * SEQ + c * CH;
        if (KIND == 0) OUT_PREF(item);
        const size_t tok = tok0 + trow;
        u32x4 pv[1][2], pc[1][2];
#define MIX_PREF(qq, bb) do { _Pragma("unroll") for (int k = 0; k < 2; ++k) { const int i = tid + k * 512; \
            pv[bb][k] = *(const u32x4*)(a.proj + (tok0 + (i >> 3)) * 3072 + 1024 + h * 256 + (qq) * 64 + (i & 7) * 8); \
            pc[bb][k] = *(const u32x4*)(a.states + ((size_t)item * 256 + (qq) * 64 + (i >> 4)) * 128 + (i & 15) * 8); } } while (0)
        MIX_PREF(0, 0);
        lds_barrier();
        if (KIND == 0) {
#pragma unroll
            for (int k = 0; k < 9; ++k) { const int q = tid + k * 512; if (q < 131 * 32) *(u32x4*)(RAW + ((q >> 4) & 1) * (131 * 128) + (q >> 5) * 128 + (q & 15) * 8) = prq[k]; }
            if (tid < 128) { fI[tid] = pg[0] + a.gateb[h]; fB[tid] = logsigf_(pg[1] + a.gateb[4 + h]); fN[tid] = pg[2]; }
        } else {
#pragma unroll
            for (int k = 0; k < 4; ++k) { const int i = tid + k * 512; *(u32x4*)(QS + (i >> 4) * LP + (i & 15) * 8) = prq[k]; *(u32x4*)(KS + (i >> 4) * LP + (i & 15) * 8) = prq[4 + k]; gl[i] = pg[k]; }
        }
        lds_barrier();
        if (KIND == 1 && item + (int)gridDim.x < 16 * NCH) OUT_PREF(item + (int)gridDim.x);
        if (KIND == 0) {
            if (tid < 64) { float x0 = fB[2 * tid], x1 = fB[2 * tid + 1]; float sc = x0 + x1;
#pragma unroll
                for (int o = 1; o < 64; o <<= 1) { const float t = __shfl_up(sc, o); if (tid >= o) sc += t; }
                fB[2 * tid] = sc - x1; fB[2 * tid + 1] = sc; }
#pragma unroll 2
            for (int i = tid; i < 128 * 32; i += 512) { const int t = (i >> 4) & 127, c8 = (i & 15) * 8, isk = i >> 11; float v[8];
                mlstm_conv8_lds(RAW + isk * (131 * 128), a.convw, t, c8, isk * 512 + h * 128 + c8, v); const float sc = isk ? 1.f : 0.08838834764831845f;
                u32x4 w; w.x = cvt_pk(v[0] * sc, v[1] * sc); w.y = cvt_pk(v[2] * sc, v[3] * sc); w.z = cvt_pk(v[4] * sc, v[5] * sc); w.w = cvt_pk(v[6] * sc, v[7] * sc);
                *(u32x4*)((isk ? KS : QS) + t * LP + c8) = w; }
        } else {
            const int ch = tid & 127, sg = tid >> 7; float w2r[16];
#pragma unroll
            for (int r = 0; r < 16; ++r) w2r[r] = a.w2[r * 512 + h * 128 + ch];
            const float gb = a.gateb[h * 128 + ch]; float ssum = 0.f;
            for (int t = sg * 32; t < sg * 32 + 32; ++t) ssum += gla_la(gl, t, w2r, gb);
            seg[sg * 128 + ch] = ssum; lds_barrier();
            float Bc = 0.f;
#pragma unroll
            for (int s2 = 0; s2 < 4; ++s2) { const float v = seg[s2 * 128 + ch]; if (s2 < sg) Bc += v; }
            for (int t = sg * 32; t < sg * 32 + 32; ++t) { Bc += gla_la(gl, t, w2r, gb);
                QS[t * LP + ch] = f2bf(bf2f(QS[t * LP + ch]) * 0.08838834764831845f * __expf(Bc)); KS[t * LP + ch] = f2bf(bf2f(KS[t * LP + ch]) * __expf(-Bc)); }
        }
        lds_barrier();
        bf16x8 qa[4];
#pragma unroll
        for (int ks = 0; ks < 4; ++ks) qa[ks] = *(const bf16x8*)(QS + trow * LP + ks * 32 + fq * 8);
        float rowsum = 0.f; const float bt = (KIND == 0) ? fB[trow] : 0.f;
        const int nmax = wid | 1;
        for (int n = 0; n <= nmax; ++n) { f32x4 s = (f32x4){0.f, 0.f, 0.f, 0.f};
            if (n <= wid) {
#pragma unroll
                for (int ks = 0; ks < 4; ++ks) { const bf16x8 kb = *(const bf16x8*)(KS + (n * 16 + fr) * LP + ks * 32 + fq * 8); s = mfma16(kb, qa[ks], s); }
#pragma unroll
                for (int j = 0; j < 4; ++j) { const int sc = n * 16 + fq * 4 + j;
                    if (sc <= trow) { if (KIND == 0) s[j] *= __expf(bt - fB[sc] + fI[sc]); } else s[j] = 0.f;
                    rowsum += s[j]; } }
            *(u32x2*)(SS + trow * LP + n * 16 + fq * 4) = pk4(s); }
        bf16x8 gtv[8];
#pragma unroll
        for (int i = 0; i < 8; ++i) gtv[i] = *(const bf16x8*)(a.proj + tok * 3072 + 2048 + h * 256 + i * 32 + fq * 8);
        f32x4 o[16];
#pragma unroll
        for (int qv = 0; qv < 4; ++qv) {
            lds_barrier();
#pragma unroll
            for (int k = 0; k < 2; ++k) { const int i = tid + k * 512; *(u32x4*)(VT + (i >> 3) * VQP + (i & 7) * 8) = pv[0][k]; *(u32x4*)(CT + (i >> 4) * LP + (i & 15) * 8) = pc[0][k]; }
            lds_barrier();
            if (qv < 3) MIX_PREF(qv + 1, 0);
#pragma unroll
            for (int n = 0; n < 4; ++n) { f32x4 ac = (f32x4){0.f, 0.f, 0.f, 0.f};
#pragma unroll
                for (int ks = 0; ks < 4; ++ks) { const bf16x8 cb = *(const bf16x8*)(CT + (32 * (n >> 1) + 8 * (fr >> 2) + 4 * (n & 1) + (fr & 3)) * LP + ks * 32 + fq * 8); ac = mfma16(cb, qa[ks], ac); }
                if (KIND == 0) ac = ac * __expf(bt);
                for (int ks = 0; ks <= (wid >> 1); ++ks) { const bf16x8 sa = *(const bf16x8*)(SS + trow * LP + ks * 32 + fq * 8); const bf16x8 vb = tr_frag_p(VT, VQP, ks * 32, n, lane); ac = mfma16(vb, sa, ac); }
                o[qv * 4 + n] = ac; }
        }
#undef MIX_PREF
        float scale = 1.f;
        if (KIND == 0) { float qn = 0.f;
#pragma unroll
            for (int i = 0; i < 32; ++i) qn += bf2f(QS[trow * LP + fq * 32 + i]) * fN[fq * 32 + i];
            qn += __shfl_xor(qn, 16); qn += __shfl_xor(qn, 32);
            rowsum += __shfl_xor(rowsum, 16); rowsum += __shfl_xor(rowsum, 32);
            const float den = rowsum + __expf(bt) * qn; scale = 1.f / fmaxf(fabsf(den), 1.f); }
        float ssq = 0.f;
#pragma unroll
        for (int i = 0; i < 16; ++i) { o[i] = o[i] * scale; ssq += o[i][0] * o[i][0] + o[i][1] * o[i][1] + o[i][2] * o[i][2] + o[i][3] * o[i][3]; }
        ssq += __shfl_xor(ssq, 16); ssq += __shfl_xor(ssq, 32);
        const float rs = rsqrtf(ssq * (1.f / 256.f) + 1e-6f);
#pragma unroll
        for (int pp = 0; pp < 8; ++pp) { const int col = h * 256 + pp * 32 + fq * 8; const f32x4 g0 = *(const f32x4*)(a.normg + col), g1 = *(const f32x4*)(a.normg + col + 4); f32x4 v0, v1;
#pragma unroll
            for (int j = 0; j < 4; ++j) { const float x0 = bf2f((u16)gtv[pp][j]), x1 = bf2f((u16)gtv[pp][4 + j]);
                v0[j] = o[2 * pp][j] * rs * g0[j] * (KIND == 0 ? sigmoidf_(x0) : siluf_(x0)); v1[j] = o[2 * pp + 1][j] * rs * g1[j] * (KIND == 0 ? sigmoidf_(x1) : siluf_(x1)); }
            *(u32x4*)(a.y + tok * DM + col) = pk8(v0, v1); }
    }
}

DEVI void s5_tables(const Params& p) {
    float* apow = (float*)(p.ws + OFF_APOW); float* bbo = (float*)(p.ws + OFF_BB);
    for (int e = obid() * 512 + otid(); e < 64 * 64; e += gridDim.x * 512) { const int g = e >> 6;
        const float lr = p.in[18][e], li = p.in[19][e]; const float dt = expf(p.in[20][g]);
        const double dlr = (double)lr * (double)dt, dli = (double)li * (double)dt;
        for (int tau = 0; tau < 34; ++tau) { const double mg = exp(dlr * tau), an = dli * tau; apow[((size_t)e * 34 + tau) * 2] = (float)(mg * cos(an)); apow[((size_t)e * 34 + tau) * 2 + 1] = (float)(mg * sin(an)); }
        const double are = exp(dlr) * cos(dli), aim = exp(dlr) * sin(dli), den = (double)lr * lr + (double)li * li;
        const double zre = ((are - 1.0) * lr + aim * li) / den, zim = (aim * lr - (are - 1.0) * li) / den;
        for (int hh = 0; hh < 16; ++hh) { const double br = p.in[21][(size_t)e * 16 + hh], bi = p.in[22][(size_t)e * 16 + hh];
            bbo[((size_t)e * 16 + hh) * 2] = (float)(zre * br - zim * bi); bbo[((size_t)e * 16 + hh) * 2 + 1] = (float)(zre * bi + zim * br); } }
}
DEVI void s5_kc(const Params& p) {
    const float* apow = (const float*)(p.ws + OFF_APOW); const float* bb = (const float*)(p.ws + OFF_BB); float* kc = (float*)(p.ws + OFF_KC);
    for (int e = obid() * 512 + otid(); e < 64 * 32 * 256; e += gridDim.x * 512) { const int h2 = e & 15, hh = (e >> 4) & 15, tau = (e >> 8) & 31, g = e >> 13; float s = 0.f;
        for (int pp = 0; pp < 64; ++pp) { const size_t gp = (size_t)g * 64 + pp; const float ar = apow[(gp * 34 + tau) * 2], ai = apow[(gp * 34 + tau) * 2 + 1];
            const float br = bb[(gp * 16 + h2) * 2], bi = bb[(gp * 16 + h2) * 2 + 1]; const float cr = p.in[23][((size_t)g * 16 + hh) * 64 + pp], ci = p.in[24][((size_t)g * 16 + hh) * 64 + pp];
            const float xr = ar * br - ai * bi, xi = ar * bi + ai * br; s += cr * xr - ci * xi; }
        kc[e] = s; }
}
DEVI void s5_fill(const Params& p) {
    const float* apow = (const float*)(p.ws + OFF_APOW); const float* bb = (const float*)(p.ws + OFF_BB); const float* kc = (const float*)(p.ws + OFF_KC);
    u16* bty = (u16*)(p.ws + OFF_BTY); u16* btg = (u16*)(p.ws + OFF_BTG);
    const int gt = obid() * 512 + otid(), nthr = gridDim.x * 512;
    for (int e = gt; e < 64 * 512 * 80; e += nthr) { const int k8 = (e % 80) * 8, n = (e / 80) & 511, g = e / (80 * 512), t = n >> 4, hh = n & 15; float v[8];
        if (k8 < 512) { const int s = k8 >> 4, h0 = k8 & 15;
#pragma unroll
            for (int j = 0; j < 8; ++j) { float x = 0.f; if (s <= t) { x = kc[(((size_t)g * 32 + (t - s)) * 16 + hh) * 16 + h0 + j]; if (s == t && h0 + j == hh) x += p.in[25][g * 16 + hh]; } v[j] = x; }
        } else { const int q0 = k8 - 512;
#pragma unroll
            for (int j = 0; j < 8; ++j) { const int q = q0 + j, pp = q & 63; const size_t gp = (size_t)g * 64 + pp; const float ar = apow[(gp * 34 + t + 1) * 2], ai = apow[(gp * 34 + t + 1) * 2 + 1];
                const float cr = p.in[23][((size_t)g * 16 + hh) * 64 + pp], ci = p.in[24][((size_t)g * 16 + hh) * 64 + pp]; v[j] = (q < 64) ? (cr * ar - ci * ai) : -(cr * ai + ci * ar); } }
        u32x4 w; w.x = cvt_pk(v[0], v[1]); w.y = cvt_pk(v[2], v[3]); w.z = cvt_pk(v[4], v[5]); w.w = cvt_pk(v[6], v[7]);
        *(u32x4*)(bty + ((size_t)g * 512 + n) * 640 + k8) = w; }
    for (int e = gt; e < 64 * 256 * 64; e += nthr) { const int k8 = (e & 63) * 8, n = (e >> 6) & 255, g = e >> 14, s = k8 >> 4, h0 = k8 & 15; float v[8];
#pragma unroll
        for (int j = 0; j < 8; ++j) { float x = 0.f; if (n < 128) { const int pp = n & 63; const size_t gp = (size_t)g * 64 + pp; const float ar = apow[(gp * 34 + 31 - s) * 2], ai = apow[(gp * 34 + 31 - s) * 2 + 1];
                const float br = bb[(gp * 16 + h0 + j) * 2], bi = bb[(gp * 16 + h0 + j) * 2 + 1]; x = (n < 64) ? (ar * br - ai * bi) : (ar * bi + ai * br); } v[j] = x; }
        u32x4 w; w.x = cvt_pk(v[0], v[1]); w.y = cvt_pk(v[2], v[3]); w.z = cvt_pk(v[4], v[5]); w.w = cvt_pk(v[6], v[7]);
        *(u32x4*)(btg + ((size_t)g * 256 + n) * 512 + k8) = w; }
}
DEVI void s5_scan(const Params& p) {
    const float* apow = (const float*)(p.ws + OFF_APOW); const float* send = (const float*)(p.ws + OFF_SEND); u16* ue = (u16*)(p.ws + OFF_UEXT);
    for (int e = obid() * 512 + otid(); e < 64 * 4 * 64; e += gridDim.x * 512) { const int pp = e & 63, b = (e >> 6) & 3, g = e >> 8;
        const float ar = apow[(((size_t)g * 64 + pp) * 34 + 32) * 2], ai = apow[(((size_t)g * 64 + pp) * 34 + 32) * 2 + 1]; float rr = 0.f, ri = 0.f;
#pragma unroll 8
        for (int c = 0; c < 256; ++c) { const size_t row = (size_t)g * 1024 + b * 256 + c; const float er = send[row * 128 + pp], ei = send[row * 128 + 64 + pp];
            ue[row * 640 + 512 + pp] = f2bf(rr); ue[row * 640 + 576 + pp] = f2bf(ri);
            const float nr = ar * rr - ai * ri + er, ni = ar * ri + ai * rr + ei; rr = nr; ri = ni; } }
}


#define XB_TMO      128
#define XB_XCNT(j)  (256  + 64 * (j))
#define XB_XSUB(j)  (1280 + 64 * (j))
#define XB_XGEN(j)  (2304 + 64 * (j))
#define XB_TOP      3328
#define XB_TOPGEN   3392
#define XCD_BAR_WORDS 3456
#define XB_SPIN_CAP (1u << 18)
DEVI unsigned xb_ld(unsigned* p)              { return __hip_atomic_load(p, __ATOMIC_RELAXED, __HIP_MEMORY_SCOPE_AGENT); }
DEVI unsigned xb_add(unsigned* p, unsigned v) { return __hip_atomic_fetch_add(p, v, __ATOMIC_RELAXED, __HIP_MEMORY_SCOPE_AGENT); }
DEVI unsigned xb_xcc_id() { return (unsigned)__builtin_amdgcn_s_getreg((3 << 11) | 20) & 0xFu; }
#define XB_SPIN(cond, bar) do { unsigned _sp = 0; while (cond) { __builtin_amdgcn_s_sleep(1); \
    if ((++_sp & 255u) == 0u) { if (xb_ld(&(bar)[XB_TMO])) break; if (_sp > XB_SPIN_CAP) { atomicAdd(&(bar)[XB_TMO], 1u); break; } } } } while (0)
struct XcdBarrier { unsigned* bar; unsigned x; volatile LAS unsigned* st; };
DEVI XcdBarrier xcd_barrier_post(unsigned* bar, volatile LAS unsigned* st) {
    XcdBarrier b; b.bar = bar; b.x = xb_xcc_id(); b.st = st;
    if (threadIdx.x == 0) (void)xb_add(&bar[XB_XCNT(b.x)], 1u);
    return b;
}
DEVI void xcd_barrier_complete(unsigned* bar, unsigned x, unsigned& nloc, unsigned& nx) {
    const unsigned G = gridDim.x * gridDim.y * gridDim.z;
    unsigned sum, cnt, mine, sp = 0u;
    for (;;) {
        sum = 0u; cnt = 0u; mine = 0u;
#pragma unroll
        for (unsigned j = 0; j < 16; ++j) { const unsigned c = xb_ld(&bar[XB_XCNT(j)]); sum += c; cnt += (c > 0u) ? 1u : 0u; mine = (j == x) ? c : mine; }
        if (sum == G) break;
        __builtin_amdgcn_s_sleep(1);
        if ((++sp & 255u) == 0u) { if (xb_ld(&bar[XB_TMO])) break; if (sp > XB_SPIN_CAP) { atomicAdd(&bar[XB_TMO], 1u); break; } }
    }
    nloc = mine > 0u ? mine : 1u; nx = cnt > 0u ? cnt : 1u;
}
DEVI void xcd_barrier(const XcdBarrier& b) {
    asm volatile("s_waitcnt vmcnt(0)" ::: "memory");
    __syncthreads();
    if (threadIdx.x == 0) {
        unsigned* bar = b.bar;
        __builtin_amdgcn_s_waitcnt(0);
        unsigned nloc = b.st[0], nx = b.st[1];
        if (nloc == 0u) { xcd_barrier_complete(bar, b.x, nloc, nx); b.st[0] = nloc; b.st[1] = nx; }
        const unsigned old = xb_add(&bar[XB_XSUB(b.x)], 1u);
        const unsigned gen = old / nloc;
        if (old + 1u == (gen + 1u) * nloc) {
            __builtin_amdgcn_fence(__ATOMIC_RELEASE, "agent");
            asm volatile("s_waitcnt vmcnt(0)" ::: "memory");
            const unsigned og = xb_add(&bar[XB_TOP], 1u);
            const unsigned tg = og / nx;
            if (og + 1u == (tg + 1u) * nx) xb_add(&bar[XB_TOPGEN], 1u);
            else XB_SPIN(xb_ld(&bar[XB_TOPGEN]) == tg, bar);
            __builtin_amdgcn_fence(__ATOMIC_ACQUIRE, "agent");
            xb_add(&bar[XB_XGEN(b.x)], 1u);
            asm volatile("s_waitcnt vmcnt(0)" ::: "memory");
        } else {
            XB_SPIN(xb_ld(&bar[XB_XGEN(b.x)]) == gen, bar);
            __builtin_amdgcn_fence(__ATOMIC_ACQUIRE, "agent");
            asm volatile("s_waitcnt vmcnt(0)" ::: "memory");
        }
    }
    __syncthreads();
}

__global__ void __launch_bounds__(512, 2) fwd_megakernel(Params p) {
    extern __shared__ __attribute__((aligned(16))) unsigned char smem[];
    cg::grid_group grid = cg::this_grid();
    LAS unsigned char* lds = (LAS unsigned char*)smem;
    unsigned char* ws = p.ws;
    u16* HN = (u16*)(ws + OFF_HN); u16* PROJ = (u16*)(ws + OFF_PROJ); float* GATES = (float*)(ws + OFF_GATES);
    float* H = p.out;
    unsigned* bar = (unsigned*)(ws + OFF_BAR);
    volatile LAS unsigned* st = (volatile LAS unsigned*)(lds + LDS_MAIN);
    if (blockIdx.x == 0) for (int i = threadIdx.x; i < XCD_BAR_WORDS; i += 512) bar[i] = 0u;
    if (threadIdx.x == 0) { st[0] = 0u; st[1] = 0u; }
    grid.sync();
    const XcdBarrier xb = xcd_barrier_post(bar, st);

    { int base = 0;
      for (int job = 0; job < 33; ++job) { const float* src; const float* gk; int K, N, Npad, mode; u16* dst; conv_job(p, job, src, K, N, dst, Npad, mode, gk);
        const int G = gridDim.x; int first = ((int)blockIdx.x - base) % G; if (first < 0) first += G;
        convT(src, K, N, dst, Npad, mode, gk, (float*)smem, first); base += (K / 64) * (Npad / 64); } }
    rms_phase(p.in[1], p.in[5], (u16*)(ws + OFF_MEMN), 1024);
    s5_tables(p);
    xcd_barrier(xb);
    { Gemm g{(const u16*)(ws + OFF_MEMN), (const u16*)(ws + OFF_W_XKV), 1024, 1024, 1024, 4, 8, 4, 0, 2048ull * 1024};
      gemm_phase(lds, g, EpiKV{(u16*)(ws + OFF_KBUF), (u16*)(ws + OFF_VT)}); }
    s5_kc(p);
    prep_phase(p.in[0], HN, (float*)(ws + OFF_SSQ));
    xcd_barrier(xb);

#pragma unroll 1
    for (int layer = 0; layer < 4; ++layer) {
        const int kind = layer % 3, j = layer / 3;
        const float* hin = layer == 0 ? p.in[0] : H;
        float* SSQ = (float*)(ws + OFF_SSQ) + (size_t)(3 * layer) * T_TOK * 4;
        if (kind != 2) {
            MixArgs a; a.proj = PROJ; a.gates = GATES; a.states = (u16*)(ws + OFF_STATES); a.dn = (float*)(ws + OFF_DN); a.dec = (float*)(ws + OFF_DEC); a.y = HN;
            const u16* wout;
            if (kind == 0) { a.convw = p.in[8] + j * 4096; a.gateb = p.in[9] + j * 8; a.w2 = nullptr; a.normg = p.in[10] + j * 1024; wout = (const u16*)(ws + OFF_W_AOUT + j * SZ_SQ);
                Gemm g{HN, (const u16*)(ws + OFF_W_AIN + j * SZ_AIN), 1024, 1024, 1024, 128, 13, 1, 0, 0}; gemm_phase(lds, g, EpiInProj{PROJ, GATES, 8, SSQ}); }
            else { a.convw = nullptr; a.gateb = p.in[14]; a.w2 = p.in[13]; a.normg = p.in[15]; wout = (const u16*)(ws + OFF_W_BOUT);
                Gemm g{HN, (const u16*)(ws + OFF_W_BIN), 1024, 1024, 1024, 128, 13, 1, 0, 0}; gemm_phase(lds, g, EpiInProj{PROJ, GATES, 16, SSQ}); }
            xcd_barrier(xb);
            if (kind == 0) mix_state_phase<0>(smem, a); else mix_state_phase<1>(smem, a);
            xcd_barrier(xb);
            mix_scan_phase(a, kind == 0);
            {
                Gemm g1{(const u16*)(ws + OFF_KBUF + layer * SZ_SQ), (const u16*)(ws + OFF_W_XQ + layer * SZ_SQ), 1024, 1024, 256, 1, 4, 16, 262144, 0}; g1.split = 1; g1.sA_lo = 256; g1.sB_lo = 256;
                gemm_phase(lds, g1, EpiG{(u16*)(ws + OFF_GBT)});
                Gemm g2{(const u16*)(ws + OFF_W_XO + layer * SZ_SQ), (const u16*)(ws + OFF_VT + layer * SZ_SQ), 1024, 1024, 256, 4, 1, 16, 0, 262144}; g2.split = 1; g2.sA_lo = 256; g2.sB_lo = 256;
                gemm_phase(lds, g2, EpiVW{(u16*)(ws + OFF_VWBT)});
            }
            xcd_barrier(xb);
            if (kind == 0) mix_out_phase<0>(smem, a); else mix_out_phase<1>(smem, a);
            xcd_barrier(xb);
            { Gemm g{HN, wout, 1024, 1024, 1024, 128, 4, 1, 0, 0}; gemm_phase(lds, g, EpiResid{hin, H, (u16*)(ws + OFF_HB), SSQ + 4 * T_TOK}); }
        } else {
            { Gemm g{HN, (const u16*)(ws + OFF_W_CIN), 1024, 1024, 1024, 128, 4, 1, 0, 0}; gemm_phase(lds, g, EpiUext{(u16*)(ws + OFF_UEXT), SSQ}); }
            s5_fill(p);
            xcd_barrier(xb);
            { Gemm g{(const u16*)(ws + OFF_UEXT), (const u16*)(ws + OFF_BTG), 640, 512, 512, 4, 1, 64, 1024ull * 640, 256ull * 512}; gemm_phase(lds, g, EpiSend{(float*)(ws + OFF_SEND)}); }
            xcd_barrier(xb);
            s5_scan(p);
            {
                Gemm g1{(const u16*)(ws + OFF_KBUF + layer * SZ_SQ), (const u16*)(ws + OFF_W_XQ + layer * SZ_SQ), 1024, 1024, 256, 1, 4, 16, 262144, 0}; g1.split = 1; g1.sA_lo = 256; g1.sB_lo = 256;
                gemm_phase(lds, g1, EpiG{(u16*)(ws + OFF_GBT)});
                Gemm g2{(const u16*)(ws + OFF_W_XO + layer * SZ_SQ), (const u16*)(ws + OFF_VT + layer * SZ_SQ), 1024, 1024, 256, 4, 1, 16, 0, 262144}; g2.split = 1; g2.sA_lo = 256; g2.sB_lo = 256;
                gemm_phase(lds, g2, EpiVW{(u16*)(ws + OFF_VWBT)});
            }
            xcd_barrier(xb);
            { Gemm g{(const u16*)(ws + OFF_UEXT), (const u16*)(ws + OFF_BTY), 640, 640, 640, 4, 2, 64, 1024ull * 640, 512ull * 640}; gemm_phase(lds, g, EpiS5Y{HN}); }
            xcd_barrier(xb);
            { Gemm g{HN, (const u16*)(ws + OFF_W_CGATE), 1024, 1024, 1024, 128, 4, 1, 0, 0}; gemm_phase(lds, g, EpiS5Gate{HN, p.in[27], (u16*)(ws + OFF_Z)}); }
            xcd_barrier(xb);
            { Gemm g{(const u16*)(ws + OFF_Z), (const u16*)(ws + OFF_W_COUT), 1024, 1024, 1024, 128, 4, 1, 0, 0}; gemm_phase(lds, g, EpiResid{hin, H, (u16*)(ws + OFF_HB), SSQ + 4 * T_TOK}); }
        }
        xcd_barrier(xb);
        { Gemm g{(const u16*)(ws + OFF_HB), (const u16*)(ws + OFF_GBT), 1024, 1024, 1024, 128, 4, 1, 0, 0}; g.pmsh = 5; g.sBpm = 1024ull * 1024;
          gemm_phase(lds, g, EpiSoftmax{(u16*)(ws + OFF_XO), SSQ + 4 * T_TOK}); }
        xcd_barrier(xb);
        { Gemm g{(const u16*)(ws + OFF_XO), (const u16*)(ws + OFF_VWBT), 1024, 1024, 1024, 128, 4, 1, 0, 0}; g.pmsh = 5; g.sBpm = 1024ull * 1024;
          gemm_phase(lds, g, EpiResid{H, H, HN, SSQ + 8 * T_TOK}); }
        xcd_barrier(xb);
        { Gemm g{HN, (const u16*)(ws + OFF_W_FGU + layer * SZ_FGU), 1024, 1024, 1024, 128, 22, 1, 0, 0}; gemm_phase(lds, g, EpiSwiglu{PROJ, SSQ + 8 * T_TOK}); }
        xcd_barrier(xb);
        { Gemm g{PROJ, (const u16*)(ws + OFF_W_FD + layer * SZ_FD), 2816, 2816, 2816, 128, 4, 1, 0, 0}; gemm_phase(lds, g, EpiResid{H, H, HN, SSQ + 12 * T_TOK}); }
        xcd_barrier(xb);
    }
    rms_final(H, p.in[6]);
}

extern "C" void kernel_launch(void* const* d_in, const int* in_sizes, int n_in, void* d_out, int out_size, void* d_ws, size_t ws_size, hipStream_t stream) {
    static int grid_blocks = 0;
    if (grid_blocks == 0) {
        if (n_in != 35 || ws_size < WS_END) { fprintf(stderr, "kernel_launch: unexpected n_in %d or ws_size %zu (need %zu)\n", n_in, ws_size, (size_t)WS_END); grid_blocks = -1; return; }
        int dev = 0, cus = 0, per_cu = 0;
        hipGetDevice(&dev);
        hipDeviceGetAttribute(&cus, hipDeviceAttributeMultiprocessorCount, dev);
        hipFuncSetAttribute((const void*)fwd_megakernel, hipFuncAttributeMaxDynamicSharedMemorySize, LDS_BYTES);
        hipOccupancyMaxActiveBlocksPerMultiprocessor(&per_cu, (const void*)fwd_megakernel, 512, LDS_BYTES);
        if (per_cu < 1) per_cu = 1;
        grid_blocks = cus * per_cu;
    }
    if (grid_blocks < 0) return;
    Params p{};
    for (int i = 0; i < 35; ++i) p.in[i] = (const float*)d_in[i];
    p.out = (float*)d_out; p.ws = (unsigned char*)d_ws;
    void* args[] = {&p};
    hipError_t e = hipLaunchCooperativeKernel((const void*)fwd_megakernel, dim3(grid_blocks), dim3(512), args, LDS_BYTES, stream);
    if (e != hipSuccess) fprintf(stderr, "cooperative launch failed: %s (grid %d)\n", hipGetErrorString(e), grid_blocks);
}
```

```cpp
#include <hip/hip_runtime.h>
#include <hip/hip_cooperative_groups.h>
#include <cstdio>
namespace cg = cooperative_groups;

typedef unsigned short u16;
typedef short bf16x8 __attribute__((ext_vector_type(8))) __attribute__((may_alias));
typedef short bf16x4 __attribute__((ext_vector_type(4))) __attribute__((may_alias));
typedef float f32x4 __attribute__((ext_vector_type(4))) __attribute__((may_alias));
typedef unsigned u32x4 __attribute__((ext_vector_type(4))) __attribute__((may_alias));
typedef unsigned u32x2 __attribute__((ext_vector_type(2))) __attribute__((may_alias));
#define LAS __attribute__((address_space(3)))
#define DEVI __device__ __forceinline__

constexpr int T_TOK = 32768, DM = 1024, SEQ = 8192;
constexpr int LDS_MAIN = 155648;
constexpr int LDS_BYTES = LDS_MAIN + 16;
constexpr int CH = 128;
constexpr int NCH = SEQ / CH;
constexpr int LP = 136;

constexpr size_t MiB = 1ull << 20;
constexpr size_t SZ_AIN = 3328ull * 1024 * 2, SZ_SQ = 1024ull * 1024 * 2, SZ_FGU = 5632ull * 1024 * 2, SZ_FD = 1024ull * 2816 * 2;
constexpr size_t OFF_W_AIN = 0;
constexpr size_t OFF_W_AOUT = OFF_W_AIN + 2 * SZ_AIN;
constexpr size_t OFF_W_BIN = OFF_W_AOUT + 2 * SZ_SQ;
constexpr size_t OFF_W_BOUT = OFF_W_BIN + SZ_AIN;
constexpr size_t OFF_W_CIN = OFF_W_BOUT + SZ_SQ;
constexpr size_t OFF_W_CGATE = OFF_W_CIN + SZ_SQ;
constexpr size_t OFF_W_COUT = OFF_W_CGATE + SZ_SQ;
constexpr size_t OFF_W_XQ = OFF_W_COUT + SZ_SQ;
constexpr size_t OFF_W_XKV = OFF_W_XQ + 4 * SZ_SQ;
constexpr size_t OFF_W_XO = OFF_W_XKV + 8 * SZ_SQ;
constexpr size_t OFF_W_FGU = OFF_W_XO + 4 * SZ_SQ;
constexpr size_t OFF_W_FD = OFF_W_FGU + 4 * SZ_FGU;
constexpr size_t OFF_MEMN = OFF_W_FD + 4 * SZ_FD;
constexpr size_t OFF_KBUF = OFF_MEMN + SZ_SQ;
constexpr size_t OFF_VT = OFF_KBUF + 4 * SZ_SQ;
constexpr size_t OFF_HN = OFF_VT + 4 * SZ_SQ;
constexpr size_t OFF_PROJ = OFF_HN + 64 * MiB;
constexpr size_t OFF_STATES = OFF_PROJ + 192 * MiB;
constexpr size_t OFF_GATES = OFF_STATES + 64 * MiB;
constexpr size_t OFF_DN = OFF_GATES + 2 * MiB;
constexpr size_t OFF_DEC = OFF_DN + MiB / 2;
constexpr size_t OFF_KC = OFF_DEC + MiB / 2;
constexpr size_t OFF_APOW = OFF_KC + 2 * MiB;
constexpr size_t OFF_BB = OFF_APOW + 5 * MiB / 4;
constexpr size_t OFF_BAR = OFF_BB + MiB / 2;
constexpr size_t OFF_SSQ = OFF_BAR + 16384;
constexpr size_t OFF_GBT = OFF_SSQ + 13ull * 32768 * 16;
constexpr size_t OFF_VWBT = OFF_GBT + 8 * MiB;
constexpr size_t WS_END = OFF_VWBT + 8 * MiB;
constexpr size_t OFF_UEXT = OFF_PROJ, OFF_SEND = OFF_PROJ + 80 * MiB, OFF_Z = OFF_PROJ + 112 * MiB;
constexpr size_t OFF_HB = OFF_PROJ, OFF_XO = OFF_PROJ + 64 * MiB, OFF_XQ = OFF_PROJ + 128 * MiB;
constexpr size_t OFF_BTY = OFF_STATES, OFF_BTG = OFF_STATES + 40 * MiB;

struct Params { const float* in[35]; float* out; unsigned char* ws; };

DEVI int otid() { int t = threadIdx.x; asm volatile("" : "+v"(t)); return t; }
DEVI int obid() { int t = blockIdx.x; asm volatile("" : "+s"(t)); return t; }
DEVI unsigned char* oput(unsigned char* q) { asm volatile("" : "+s"(q)); return q; }
DEVI float bf2f(u16 b) { return __uint_as_float(((unsigned)b) << 16); }
typedef __bf16 bf16v2_t __attribute__((ext_vector_type(2)));
typedef float f32v2_t __attribute__((ext_vector_type(2)));
DEVI unsigned cvt_pk(float lo, float hi) { f32v2_t f = {lo, hi}; bf16v2_t v = __builtin_convertvector(f, bf16v2_t); return __builtin_bit_cast(unsigned, v); }
DEVI u16 f2bf(float f) { return (u16)(cvt_pk(f, 0.f) & 0xffffu); }
DEVI u32x2 pk4(f32x4 v) { u32x2 r; r.x = cvt_pk(v[0], v[1]); r.y = cvt_pk(v[2], v[3]); return r; }
DEVI float sigmoidf_(float x) { return __builtin_amdgcn_rcpf(1.f + __expf(-x)); }
DEVI float siluf_(float x) { return x * __builtin_amdgcn_rcpf(1.f + __expf(-x)); }
DEVI float logsigf_(float x) { return fminf(x, 0.f) - __logf(1.f + __expf(-fabsf(x))); }
DEVI float gelu_tanh(float x) { const float u = 0.7978845608028654f * (x + 0.044715f * x * x * x); return x * sigmoidf_(2.f * u); }
DEVI void lds_barrier() { asm volatile("s_waitcnt lgkmcnt(0)\n\ts_barrier" ::: "memory"); }
DEVI f32x4 mfma16(bf16x8 a, bf16x8 b, f32x4 c) { return __builtin_amdgcn_mfma_f32_16x16x32_bf16(a, b, c, 0, 0, 0); }

constexpr int BM = 256, BK = 64, HALF = 128, HTB = HALF * BK * 2, NXCD = 8, WGM = 8;
DEVI int lds_byte(int r, int c) { const int st = (r >> 4) * 2 + (c >> 5), rr = r & 15, cc = c & 31, ob = rr * 64 + cc * 2; return st * 1024 + (ob ^ (((ob >> 9) & 1) << 5)); }
DEVI void stage_rc(int b, int& R, int& C) { const int st = b / 1024, sb = b % 1024, swz = sb ^ (((sb >> 9) & 1) << 5); R = (st >> 1) * 16 + swz / 64; C = (st & 1) * 32 + (swz % 64) / 2; }

DEVI int perm32(int rho) { const int n = rho >> 4, i = rho & 15; return 8 * (i >> 2) + 4 * n + (i & 3); }
struct Unit { int pm, pn, b; };
struct Gemm { const u16* A; const u16* Bt; int lda, ldb, K, nM, nN, nB; size_t sA, sB;
    int split = 0; size_t sA_lo = 0, sB_lo = 0;
    int pmsh = 31; size_t sBpm = 0;
    int wg_off = 0; };
DEVI size_t gemm_offA(const Gemm& g, const Unit& u) { return g.split ? (size_t)(u.b >> 2) * g.sA + (size_t)(u.b & 3) * g.sA_lo : (size_t)u.b * g.sA; }
DEVI size_t gemm_offB(const Gemm& g, const Unit& u) { return (g.split ? (size_t)(u.b >> 2) * g.sB + (size_t)(u.b & 3) * g.sB_lo : (size_t)u.b * g.sB) + (size_t)(u.pm >> g.pmsh) * g.sBpm; }

DEVI bool unit_next(const Gemm& g, int i, Unit& u) {
    const int nwg = g.nM * g.nN; int cc = obid() - g.wg_off; if (cc < 0) cc += gridDim.x; const long L = (long)i * gridDim.x + cc;
    if (L >= (long)nwg * g.nB) return false;
    u.b = (int)(L / nwg); int wgid = (int)(L % nwg);
    { const int q = nwg / NXCD, r = nwg % NXCD, xcd = wgid % NXCD, off = wgid / NXCD; wgid = (xcd < r ? xcd * (q + 1) : r * (q + 1) + (xcd - r) * q) + off; }
    const int nig = WGM * g.nN, gid = wgid / nig, fm = gid * WGM, gsz = (g.nM - fm) < WGM ? (g.nM - fm) : WGM;
    u.pm = fm + ((wgid % nig) % gsz); u.pn = (wgid % nig) / gsz; return true;
}

DEVI u32x4 pk8(f32x4 a, f32x4 b);
template <class Epi>
DEVI void gemm_phase(LAS unsigned char* lds, const Gemm g, const Epi& E) {
    const int tid = otid(), wid = __builtin_amdgcn_readfirstlane(tid >> 6), lane = tid & 63, wr = wid >> 2, wc = wid & 3, fr = lane & 15, fq = lane >> 4;
    const int nt = g.K / BK;
    unsigned voffA[2], voffB[2];
#pragma unroll
    for (int i = 0; i < 2; ++i) { int R, C; stage_rc(tid * 16 + i * 8192, R, C); voffA[i] = (unsigned)(R * g.lda + C) * 2u; const int Rb = Epi::PERM ? ((R & ~31) + perm32(R & 31)) : R; voffB[i] = (unsigned)(Rb * g.ldb + C) * 2u; }
    const size_t kstep = (size_t)(BK * 2);
    const size_t hstepA = (size_t)HALF * g.lda * 2, hstepB = (size_t)HALF * g.ldb * 2;
    const size_t tstepA = 2 * hstepA, tstepB = 2 * hstepB;
    const unsigned ldsw = (unsigned)wid * 1024u;
    const int aoff = lds_byte(wr * 64 + fr, fq * 8), boff = lds_byte(wc * 32 + fr, fq * 8);
#define PG8_SA(b, h) (((b) * 2 + (h)) * HTB)
#define PG8_SB(b, h) ((4 + (b) * 2 + (h)) * HTB)
#define PG8_STAGE(bufoff, gbase, voff) do { _Pragma("unroll") for (int _i = 0; _i < 2; ++_i) \
        __builtin_amdgcn_global_load_lds((const unsigned*)((const char*)(gbase) + (voff)[_i]), (LAS unsigned*)(lds + (bufoff) + ldsw + _i * 8192), 16, 0, 0); } while (0)
#define PG8_LDA(dst, b, h) do { _Pragma("unroll") for (int m = 0; m < 4; ++m) _Pragma("unroll") for (int k = 0; k < 2; ++k) dst[m][k] = *(const LAS bf16x8*)(lds + PG8_SA(b, h) + aoff + m * 2048 + k * 1024); } while (0)
#define PG8_LDB(dst, b, h) do { _Pragma("unroll") for (int n = 0; n < 2; ++n) _Pragma("unroll") for (int k = 0; k < 2; ++k) dst[n][k] = *(const LAS bf16x8*)(lds + PG8_SB(b, h) + boff + n * 2048 + k * 1024); } while (0)
#define PG8_MMA(ai, bj, At, Bt) do { __builtin_amdgcn_s_setprio(1); _Pragma("unroll") for (int m = 0; m < 4; ++m) _Pragma("unroll") for (int n = 0; n < 2; ++n) _Pragma("unroll") for (int k = 0; k < 2; ++k) \
        acc[ai][bj][m][n] = __builtin_amdgcn_mfma_f32_16x16x32_bf16(Bt[n][k], At[m][k], acc[ai][bj][m][n], 0, 0, 0); __builtin_amdgcn_s_setprio(0); } while (0)
#define PG8_WAIT_V(n) asm volatile("s_waitcnt vmcnt(" #n ")" ::: "memory")
#define PG8_WAIT_L(n) asm volatile("s_waitcnt lgkmcnt(" #n ")" ::: "memory")
#define PG8_BAR __builtin_amdgcn_s_barrier()
#define PG8_SCHED __builtin_amdgcn_sched_barrier(0)
    Unit cur, nxt; int ui = 0;
    if (!unit_next(g, 0, cur)) return;
    f32x4 acc[2][2][4][2];
#pragma unroll
    for (int a = 0; a < 2; ++a)
#pragma unroll
        for (int b = 0; b < 2; ++b)
#pragma unroll
            for (int m = 0; m < 4; ++m)
#pragma unroll
                for (int n = 0; n < 2; ++n) acc[a][b][m][n] = (f32x4){0.f, 0.f, 0.f, 0.f};
    bf16x8 At[4][2], B0[2][2], B1[2][2];
    const char* cA = (const char*)g.A + gemm_offA(g, cur) * 2 + (size_t)cur.pm * tstepA;
    const char* cB = (const char*)g.Bt + gemm_offB(g, cur) * 2 + (size_t)cur.pn * tstepB;
    PG8_STAGE(PG8_SB(0, 0), cB, voffB); PG8_STAGE(PG8_SA(0, 0), cA, voffA); PG8_STAGE(PG8_SB(0, 1), cB + hstepB, voffB); PG8_STAGE(PG8_SA(0, 1), cA + hstepA, voffA);
    if (wr == 1) PG8_BAR;
    PG8_WAIT_V(4); PG8_BAR;
    PG8_STAGE(PG8_SB(1, 0), cB + kstep, voffB); PG8_STAGE(PG8_SA(1, 0), cA + kstep, voffA); PG8_STAGE(PG8_SB(1, 1), cB + hstepB + kstep, voffB);
    PG8_WAIT_V(6); PG8_BAR;
    for (;;) {
        const bool has_next = unit_next(g, ui + 1, nxt);
        const char* nA = has_next ? (const char*)g.A + gemm_offA(g, nxt) * 2 + (size_t)nxt.pm * tstepA : cA;
        const char* nB = has_next ? (const char*)g.Bt + gemm_offB(g, nxt) * 2 + (size_t)nxt.pn * tstepB : cB;
        for (int t = 0; t < nt; t += 2) {
            const bool last = (t == nt - 2);
            const char* a1 = cA + (size_t)(t + 1) * kstep;
            const char* a2 = last ? nA : cA + (size_t)(t + 2) * kstep; const char* b2 = last ? nB : cB + (size_t)(t + 2) * kstep;
            const char* a3 = a2 + kstep; const char* b3 = b2 + kstep;
            PG8_LDB(B0, 0, 0); PG8_SCHED; PG8_LDA(At, 0, 0); PG8_STAGE(PG8_SA(1, 1), a1 + hstepA, voffA);
            PG8_WAIT_L(8); PG8_BAR; PG8_WAIT_L(0); PG8_MMA(0, 0, At, B0); PG8_BAR; PG8_SCHED;
            PG8_LDB(B1, 0, 1); PG8_STAGE(PG8_SB(0, 0), b2, voffB);
            PG8_BAR; PG8_WAIT_L(0); PG8_MMA(0, 1, At, B1); PG8_BAR;
            PG8_LDA(At, 0, 1); PG8_STAGE(PG8_SA(0, 0), a2, voffA);
            PG8_BAR; PG8_WAIT_L(0); PG8_MMA(1, 0, At, B0); PG8_BAR; PG8_SCHED;
            PG8_STAGE(PG8_SB(0, 1), b2 + hstepB, voffB);
            PG8_WAIT_V(6); PG8_BAR; PG8_MMA(1, 1, At, B1); PG8_BAR;
            PG8_LDB(B0, 1, 0); PG8_SCHED; PG8_LDA(At, 1, 0); PG8_STAGE(PG8_SA(0, 1), a2 + hstepA, voffA);
            PG8_WAIT_L(8); PG8_BAR; PG8_WAIT_L(0); PG8_MMA(0, 0, At, B0); PG8_BAR; PG8_SCHED;
            PG8_LDB(B1, 1, 1); PG8_STAGE(PG8_SB(1, 0), b3, voffB);
            PG8_BAR; PG8_WAIT_L(0); PG8_MMA(0, 1, At, B1); PG8_BAR;
            PG8_LDA(At, 1, 1); PG8_STAGE(PG8_SA(1, 0), a3, voffA);
            PG8_BAR; PG8_WAIT_L(0); PG8_MMA(1, 0, At, B0); PG8_BAR; PG8_SCHED;
            PG8_STAGE(PG8_SB(1, 1), b3 + hstepB, voffB);
            PG8_WAIT_V(6); PG8_BAR; PG8_MMA(1, 1, At, B1); PG8_BAR;
        }
        {
            const int row0 = cur.pm * BM + wr * 64 + fr, col0 = cur.pn * BM + wc * 32 + (Epi::PERM ? 8 : 4) * fq; constexpr int NST = Epi::PERM ? 4 : 16;
            float rsv[8];
            if constexpr (Epi::RS) { f32x4 q4[8];
#pragma unroll
                for (int i = 0; i < 8; ++i) q4[i] = *(const f32x4*)(E.ssq_in + (size_t)(row0 + (i >> 2) * HALF + (i & 3) * 16) * 4);
#pragma unroll
                for (int i = 0; i < 8; ++i) rsv[i] = rsqrtf((((q4[i][0] + q4[i][1]) + q4[i][2]) + q4[i][3]) * (1.f / DM) + 1e-6f); }
            if constexpr (Epi::SOFTMAX) {
                LAS float* red = (LAS float*)(lds + 131072);
#pragma unroll
                for (int ai = 0; ai < 2; ++ai)
#pragma unroll
                    for (int m = 0; m < 4; ++m) { const float sc = rsv[ai * 4 + m] * 0.0625f; float part = 0.f;
#pragma unroll
                        for (int bj = 0; bj < 2; ++bj)
#pragma unroll
                            for (int n = 0; n < 2; ++n)
#pragma unroll
                                for (int j = 0; j < 4; ++j) { const float e = __expf(fmaxf(fminf(acc[ai][bj][m][n][j] * sc, 80.f), -80.f)); acc[ai][bj][m][n][j] = e; part += e; }
                        part += __shfl_xor(part, 16); part += __shfl_xor(part, 32);
                        if (fq == 0) red[(wr * 4 + wc) * 128 + ai * 64 + m * 16 + fr] = part; }
                PG8_WAIT_L(0); PG8_BAR;
#pragma unroll
                for (int ai = 0; ai < 2; ++ai)
#pragma unroll
                    for (int m = 0; m < 4; ++m) { const LAS float* rr = red + wr * 512 + ai * 64 + m * 16 + fr;
                        const float inv = __builtin_amdgcn_rcpf(((rr[0] + rr[128]) + rr[256]) + rr[384]); const int r = row0 + ai * HALF + m * 16;
#pragma unroll
                        for (int bj = 0; bj < 2; ++bj) *(u32x4*)(E.P + (size_t)r * DM + col0 + bj * HALF) = pk8(acc[ai][bj][m][0] * inv, acc[ai][bj][m][1] * inv); }
            } else
#pragma unroll
            for (int am = 0; am < 4; ++am) {
                const int ai = am >> 1, m0 = (am & 1) * 2;
                f32x4 pre[2][2][2];
                if constexpr (Epi::PRE) {
#pragma unroll
                    for (int m = 0; m < 2; ++m)
#pragma unroll
                        for (int bj = 0; bj < 2; ++bj)
#pragma unroll
                            for (int n = 0; n < 2; ++n) pre[m][bj][n] = E.load(row0 + ai * HALF + (m0 + m) * 16, col0 + bj * HALF + n * NST);
                }
#pragma unroll
                for (int mm = 0; mm < 2; ++mm) {
                    const int m = m0 + mm;
                    const int r = row0 + ai * HALF + m * 16; float rs = 1.f, part = 0.f;
                    if constexpr (Epi::RS) rs = rsv[ai * 4 + m];
                    if constexpr (Epi::PAIR) E.pair8(cur.b, r, cur.pn * HALF + wc * 32 + 8 * fq, acc[ai][0][m][0] * rs, acc[ai][0][m][1] * rs, acc[ai][1][m][0] * rs, acc[ai][1][m][1] * rs);
                    else
#pragma unroll
                    for (int bj = 0; bj < 2; ++bj) {
                        const int c = col0 + bj * HALF; f32x4 v0 = acc[ai][bj][m][0], v1 = acc[ai][bj][m][1];
                        if constexpr (Epi::RS) { v0 = v0 * rs; v1 = v1 * rs; }
                        if constexpr (Epi::PRE) part += E.frag_pre8(cur.b, r, c, v0, v1, pre[mm][bj][0], pre[mm][bj][1]);
                        else if constexpr (Epi::PERM) E.frag8(cur.b, r, c, v0, v1);
                        else { E.frag(cur.b, r, c, v0); E.frag(cur.b, r, c + 16, v1); }
                    }
                    if constexpr (Epi::SSQ) { part += __shfl_xor(part, 16); part += __shfl_xor(part, 32); if (fq == 0) ((LAS float*)(lds + 131072))[(wr * 4 + wc) * 128 + ai * 64 + m * 16 + fr] = part; }
                }
            }
            if constexpr (Epi::SSQ) {
                PG8_WAIT_L(0); PG8_BAR;
                if (lane < 32) { const int rl = wc * 32 + lane; const LAS float* red = (const LAS float*)(lds + 131072) + wr * 512 + rl;
                    const float sum = ((red[0] + red[128]) + red[256]) + red[384];
                    E.ssq_out[(size_t)(cur.pm * BM + (rl >> 6) * HALF + wr * 64 + (rl & 63)) * 4 + cur.pn] = sum; }
            }
        }
        if (!has_next) break;
#pragma unroll
        for (int a = 0; a < 2; ++a)
#pragma unroll
            for (int b = 0; b < 2; ++b)
#pragma unroll
                for (int m = 0; m < 4; ++m)
#pragma unroll
                    for (int n = 0; n < 2; ++n) acc[a][b][m][n] = (f32x4){0.f, 0.f, 0.f, 0.f};
        cur = nxt; cA = nA; cB = nB; ++ui;
    }
    PG8_WAIT_V(0);
    if (wr == 0) PG8_BAR;
    PG8_BAR;
#undef PG8_SA
#undef PG8_SB
#undef PG8_STAGE
#undef PG8_LDA
#undef PG8_LDB
#undef PG8_MMA
#undef PG8_WAIT_V
#undef PG8_WAIT_L
#undef PG8_BAR
#undef PG8_SCHED
}

DEVI u32x4 pk8(f32x4 a, f32x4 b) { u32x4 w; w.x = cvt_pk(a[0], a[1]); w.y = cvt_pk(a[2], a[3]); w.z = cvt_pk(b[0], b[1]); w.w = cvt_pk(b[2], b[3]); return w; }
struct EpiBf16 { static constexpr bool PAIR = false, RS = true, SSQ = false, PRE = false, PERM = true, SOFTMAX = false; u16* O; int ldc; const float* ssq_in;
    DEVI void frag8(int, int r, int c, f32x4 v0, f32x4 v1) const { *(u32x4*)(O + (size_t)r * ldc + c) = pk8(v0, v1); } };
struct EpiInProj { static constexpr bool PAIR = false, RS = true, SSQ = false, PRE = false, PERM = true, SOFTMAX = false; u16* O; float* gates; int ngate; const float* ssq_in;
    DEVI void frag8(int, int r, int c, f32x4 v0, f32x4 v1) const {
        if (c < 3072) *(u32x4*)(O + (size_t)r * 3072 + c) = pk8(v0, v1);
        else if (c - 3072 < ngate) { float* gp = gates + (size_t)r * 16 + (c - 3072); *(f32x4*)gp = v0; *(f32x4*)(gp + 4) = v1; } } };
struct EpiResid { static constexpr bool PAIR = false, RS = false, SSQ = true, PRE = true, PERM = true, SOFTMAX = false; const float* hin; float* hout; u16* hb; float* ssq_out;
    DEVI f32x4 load(int r, int c) const { return *(const f32x4*)(hin + (size_t)r * DM + c); }
    DEVI float frag_pre8(int, int r, int c, f32x4 v0, f32x4 v1, f32x4 p0, f32x4 p1) const { const size_t o = (size_t)r * DM + c; const f32x4 h0 = p0 + v0, h1 = p1 + v1;
        *(f32x4*)(hout + o) = h0; *(f32x4*)(hout + o + 4) = h1; *(u32x4*)(hb + o) = pk8(h0, h1);
        return ((h0[0] * h0[0] + h0[1] * h0[1]) + (h0[2] * h0[2] + h0[3] * h0[3])) + ((h1[0] * h1[0] + h1[1] * h1[1]) + (h1[2] * h1[2] + h1[3] * h1[3])); } };
struct EpiSwiglu { static constexpr bool PAIR = true, RS = true, SSQ = false, PRE = false, PERM = true, SOFTMAX = false; u16* O; const float* ssq_in;
    DEVI void pair8(int, int r, int c, f32x4 g0, f32x4 g1, f32x4 u0, f32x4 u1) const { f32x4 a, b;
#pragma unroll
        for (int j = 0; j < 4; ++j) { a[j] = siluf_(g0[j]) * u0[j]; b[j] = siluf_(g1[j]) * u1[j]; }
        *(u32x4*)(O + (size_t)r * 2816 + c) = pk8(a, b); } };
struct EpiKV { static constexpr bool PAIR = false, RS = false, SSQ = false, PRE = false, PERM = true, SOFTMAX = false; u16* kbuf; u16* vbuf;
    DEVI void frag8(int l, int r, int c, f32x4 v0, f32x4 v1) const { u16* base = c < 1024 ? kbuf : vbuf; *(u32x4*)(base + (size_t)l * 1024 * 1024 + (size_t)r * 1024 + (c & 1023)) = pk8(v0, v1); } };
struct EpiG { static constexpr bool PAIR = false, RS = false, SSQ = false, PRE = false, PERM = true, SOFTMAX = false; u16* G;
    DEVI void frag8(int bh, int r, int c, f32x4 v0, f32x4 v1) const { *(u32x4*)(G + ((size_t)(bh >> 2) * 1024 + (bh & 3) * 256 + r) * 1024 + c) = pk8(v0, v1); } };
struct EpiVW { static constexpr bool PAIR = false, RS = false, SSQ = false, PRE = false, PERM = true, SOFTMAX = false; u16* VW;
    DEVI void frag8(int bh, int r, int c, f32x4 v0, f32x4 v1) const { *(u32x4*)(VW + ((size_t)(bh >> 2) * 1024 + r) * 1024 + (bh & 3) * 256 + c) = pk8(v0, v1); } };
struct EpiSoftmax { static constexpr bool PAIR = false, RS = true, SSQ = false, PRE = false, PERM = true, SOFTMAX = true; u16* P; const float* ssq_in; };
struct EpiUext { static constexpr bool PAIR = false, RS = true, SSQ = false, PRE = false, PERM = true, SOFTMAX = false; u16* U; const float* ssq_in;
    DEVI void frag8(int, int r, int c, f32x4 v0, f32x4 v1) const { *(u32x4*)(U + ((size_t)(c >> 4) * 1024 + (r >> 5)) * 640 + (r & 31) * 16 + (c & 15)) = pk8(v0, v1); } };
struct EpiSend { static constexpr bool PAIR = false, RS = false, SSQ = false, PRE = false, PERM = false, SOFTMAX = false; float* S;
    DEVI void frag(int g, int r, int c, f32x4 v) const { if (c < 128) *(f32x4*)(S + ((size_t)g * 1024 + r) * 128 + c) = v; } };
struct EpiS5Y { static constexpr bool PAIR = false, RS = false, SSQ = false, PRE = false, PERM = true, SOFTMAX = false; u16* Y;
    DEVI void frag8(int g, int r, int c, f32x4 v0, f32x4 v1) const { f32x4 o0, o1;
#pragma unroll
        for (int j = 0; j < 4; ++j) { o0[j] = gelu_tanh(v0[j]); o1[j] = gelu_tanh(v1[j]); }
        *(u32x4*)(Y + ((size_t)r * 32 + (c >> 4)) * DM + g * 16 + (c & 15)) = pk8(o0, o1); } };
struct EpiS5Gate { static constexpr bool PAIR = false, RS = false, SSQ = false, PRE = true, PERM = true, SOFTMAX = false; const u16* Y; const float* bg; u16* Z;
    DEVI f32x4 load(int r, int c) const { const bf16x4 y = *(const bf16x4*)(Y + (size_t)r * DM + c); return (f32x4){bf2f((u16)y[0]), bf2f((u16)y[1]), bf2f((u16)y[2]), bf2f((u16)y[3])}; }
    DEVI float frag_pre8(int, int r, int c, f32x4 v0, f32x4 v1, f32x4 y0, f32x4 y1) const { const f32x4 b0 = *(const f32x4*)(bg + c), b1 = *(const f32x4*)(bg + c + 4); f32x4 z0, z1;
#pragma unroll
        for (int j = 0; j < 4; ++j) { z0[j] = y0[j] * sigmoidf_(v0[j] + b0[j]); z1[j] = y1[j] * sigmoidf_(v1[j] + b1[j]); }
        *(u32x4*)(Z + (size_t)r * DM + c) = pk8(z0, z1); return 0.f; } };

DEVI void convT(const float* src, int K, int N, u16* dst, int Npad, int mode, const float* gk, float* tile, int first) {
    const int tid = otid(), ntk = K / 64, ntn = Npad / 64;
    for (int ti = first; ti < ntk * ntn; ti += gridDim.x) {
        const int k0 = (ti % ntk) * 64, n0 = (ti / ntk) * 64;
        for (int i = tid; i < 1024; i += 512) { const int kk = i >> 4, n4 = (i & 15) * 4, n = n0 + n4;
            f32x4 v = (f32x4){0.f, 0.f, 0.f, 0.f}; if (n < N) { v = *(const f32x4*)(src + (size_t)(k0 + kk) * N + n); if (gk) v = v * gk[k0 + kk]; }
            float* tp = tile + kk * 65 + n4; tp[0] = v[0]; tp[1] = v[1]; tp[2] = v[2]; tp[3] = v[3]; }
        __syncthreads();
        if (mode == 3) { const int kk = tid >> 3, n8 = (tid & 7) * 8; const float* tp = tile + kk * 65 + n8;
          u32x4 w; w.x = cvt_pk(tp[0], tp[1]); w.y = cvt_pk(tp[2], tp[3]); w.z = cvt_pk(tp[4], tp[5]); w.w = cvt_pk(tp[6], tp[7]);
          *(u32x4*)(dst + (size_t)(k0 + kk) * N + n0 + n8) = w; }
        else { const int nn = tid >> 3, k8 = (tid & 7) * 8; const int n = n0 + nn;
          int row = n; if (mode == 1) row = 256 * (n >> 7) + (n & 127); else if (mode == 2) row = 256 * (n >> 7) + 128 + (n & 127);
          u32x4 w; w.x = cvt_pk(tile[(k8 + 0) * 65 + nn], tile[(k8 + 1) * 65 + nn]); w.y = cvt_pk(tile[(k8 + 2) * 65 + nn], tile[(k8 + 3) * 65 + nn]);
          w.z = cvt_pk(tile[(k8 + 4) * 65 + nn], tile[(k8 + 5) * 65 + nn]); w.w = cvt_pk(tile[(k8 + 6) * 65 + nn], tile[(k8 + 7) * 65 + nn]);
          *(u32x4*)(dst + (size_t)row * K + k0 + k8) = w; }
        __syncthreads();
    }
}
DEVI void conv_job(const Params& p, int job, const float*& src, int& K, int& N, u16*& dst, int& Npad, int& mode, const float*& gk) {
    unsigned char* ws = p.ws; K = 1024; N = 1024; Npad = 1024; mode = 0; gk = nullptr;
    if (job < 2) { src = p.in[7] + (size_t)job * 1024 * 3080; N = 3080; Npad = 3328; dst = (u16*)(ws + OFF_W_AIN + job * SZ_AIN); gk = p.in[2] + 3 * job * DM; }
    else if (job < 4) { src = p.in[11] + (size_t)(job - 2) * 1024 * 1024; dst = (u16*)(ws + OFF_W_AOUT + (job - 2) * SZ_SQ); }
    else if (job == 4) { src = p.in[12]; N = 3088; Npad = 3328; dst = (u16*)(ws + OFF_W_BIN); gk = p.in[2] + 1 * DM; }
    else if (job == 5) { src = p.in[16]; dst = (u16*)(ws + OFF_W_BOUT); }
    else if (job == 6) { src = p.in[17]; dst = (u16*)(ws + OFF_W_CIN); gk = p.in[2] + 2 * DM; }
    else if (job == 7) { src = p.in[26]; dst = (u16*)(ws + OFF_W_CGATE); }
    else if (job == 8) { src = p.in[28]; dst = (u16*)(ws + OFF_W_COUT); }
    else if (job < 13) { const int i = job - 9; src = p.in[29] + (size_t)i * 1024 * 1024; dst = (u16*)(ws + OFF_W_XQ + i * SZ_SQ); gk = p.in[3] + i * DM; mode = 3; }
    else if (job < 17) { const int i = job - 13; src = p.in[30] + (size_t)i * 1024 * 2048; N = 2048; Npad = 2048; dst = (u16*)(ws + OFF_W_XKV + i * 2 * SZ_SQ); }
    else if (job < 21) { const int i = job - 17; src = p.in[31] + (size_t)i * 1024 * 1024; dst = (u16*)(ws + OFF_W_XO + i * SZ_SQ); }
    else if (job < 25) { const int i = job - 21; src = p.in[32] + (size_t)i * 1024 * 2816; N = 2816; Npad = 2816; mode = 1; dst = (u16*)(ws + OFF_W_FGU + i * SZ_FGU); gk = p.in[4] + i * DM; }
    else if (job < 29) { const int i = job - 25; src = p.in[33] + (size_t)i * 1024 * 2816; N = 2816; Npad = 2816; mode = 2; dst = (u16*)(ws + OFF_W_FGU + i * SZ_FGU); gk = p.in[4] + i * DM; }
    else { const int i = job - 29; src = p.in[34] + (size_t)i * 2816 * 1024; K = 2816; dst = (u16*)(ws + OFF_W_FD + i * SZ_FD); }
}

DEVI void rms_phase(const float* src, const float* g, u16* dst, int rows) {
    const int lane = otid() & 63, gw = obid() * 8 + (otid() >> 6), nw = gridDim.x * 8;
    f32x4 gv[4];
#pragma unroll
    for (int i = 0; i < 4; ++i) gv[i] = *(const f32x4*)(g + i * 256 + lane * 4);
    for (int r = gw; r < rows; r += nw) {
        const float* s = src + (size_t)r * DM; f32x4 v[4]; float ss = 0.f;
#pragma unroll
        for (int i = 0; i < 4; ++i) { v[i] = *(const f32x4*)(s + i * 256 + lane * 4); ss += v[i][0] * v[i][0] + v[i][1] * v[i][1] + v[i][2] * v[i][2] + v[i][3] * v[i][3]; }
#pragma unroll
        for (int o = 32; o > 0; o >>= 1) ss += __shfl_xor(ss, o);
        const float rs = rsqrtf(ss * (1.f / DM) + 1e-6f);
#pragma unroll
        for (int i = 0; i < 4; ++i) *(u32x2*)(dst + (size_t)r * DM + i * 256 + lane * 4) = pk4(v[i] * rs * gv[i]);
    }
}
DEVI void prep_phase(const float* src, u16* dst, float* ssq) {
    const int lane = otid() & 63, gw = obid() * 8 + (otid() >> 6), nw = gridDim.x * 8;
    for (int r = gw; r < T_TOK; r += nw) {
        const float* s = src + (size_t)r * DM; f32x4 v[4]; float ss = 0.f;
#pragma unroll
        for (int i = 0; i < 4; ++i) { v[i] = *(const f32x4*)(s + i * 256 + lane * 4); ss += v[i][0] * v[i][0] + v[i][1] * v[i][1] + v[i][2] * v[i][2] + v[i][3] * v[i][3]; }
#pragma unroll
        for (int o = 32; o > 0; o >>= 1) ss += __shfl_xor(ss, o);
#pragma unroll
        for (int i = 0; i < 4; ++i) *(u32x2*)(dst + (size_t)r * DM + i * 256 + lane * 4) = pk4(v[i]);
        if (lane == 0) *(f32x4*)(ssq + (size_t)r * 4) = (f32x4){ss, 0.f, 0.f, 0.f};
    }
}
DEVI void rms_final(float* io, const float* g) {
    const int lane = otid() & 63, gw = obid() * 8 + (otid() >> 6), nw = gridDim.x * 8;
    f32x4 gv[4];
#pragma unroll
    for (int i = 0; i < 4; ++i) gv[i] = *(const f32x4*)(g + i * 256 + lane * 4);
    for (int r = gw; r < T_TOK; r += nw) {
        float* s = io + (size_t)r * DM; f32x4 v[4]; float ss = 0.f;
#pragma unroll
        for (int i = 0; i < 4; ++i) { v[i] = *(const f32x4*)(s + i * 256 + lane * 4); ss += v[i][0] * v[i][0] + v[i][1] * v[i][1] + v[i][2] * v[i][2] + v[i][3] * v[i][3]; }
#pragma unroll
        for (int o = 32; o > 0; o >>= 1) ss += __shfl_xor(ss, o);
        const float rs = rsqrtf(ss * (1.f / DM) + 1e-6f);
#pragma unroll
        for (int i = 0; i < 4; ++i) *(f32x4*)(s + i * 256 + lane * 4) = v[i] * rs * gv[i];
    }
}

constexpr int KVP = 264;
DEVI void attn_stage(u16* img, const u16* src, int rstride, int tid) {
#pragma unroll
    for (int it = 0; it < 2; ++it) { u32x4 v[8];
#pragma unroll
        for (int k = 0; k < 8; ++k) { const int i = tid + (it * 8 + k) * 512, r = i >> 5, c8 = (i & 31) * 8; v[k] = *(const u32x4*)(src + (size_t)r * rstride + c8); }
#pragma unroll
        for (int k = 0; k < 8; ++k) { const int i = tid + (it * 8 + k) * 512, r = i >> 5, c8 = (i & 31) * 8; *(u32x4*)(img + r * KVP + c8) = v[k]; } }
}
DEVI void attn_phase(unsigned char* smem, const u16* Q, const u16* Kb, const u16* Vt, u16* O) {
    const int tid = otid(), wid = tid >> 6, lane = tid & 63, fr = lane & 15, fq = lane >> 4;
    u16* img = (u16*)smem;
    for (int item = obid(); item < 1024; item += gridDim.x) {
        const int qb = item & 63, bh = item >> 6, h = bh & 3, b = bh >> 2;
        lds_barrier();
        attn_stage(img, Kb + (size_t)(b * 256) * DM + h * 256, DM, tid);
        lds_barrier();
        bf16x8 pb[1][8]; float inv[1];
#pragma unroll
        for (int rb = 0; rb < 1; ++rb) {
            const size_t qrow = (size_t)b * SEQ + qb * 128 + rb * 128 + wid * 16 + fr;
            const u16* q = Q + qrow * DM + h * 256 + fq * 8;
            bf16x8 qf[8];
#pragma unroll
            for (int ks = 0; ks < 8; ++ks) qf[ks] = *(const bf16x8*)(q + ks * 32);
            f32x4 s[16];
#pragma unroll
            for (int kt = 0; kt < 16; ++kt) { s[kt] = (f32x4){0.f, 0.f, 0.f, 0.f};
#pragma unroll
                for (int ks = 0; ks < 8; ++ks) { const bf16x8 a = *(const bf16x8*)(img + (kt * 16 + fr) * KVP + ks * 32 + fq * 8); s[kt] = mfma16(a, qf[ks], s[kt]); } }
            float mx = -3.0e38f;
#pragma unroll
            for (int kt = 0; kt < 16; ++kt)
#pragma unroll
                for (int j = 0; j < 4; ++j) mx = fmaxf(mx, s[kt][j]);
            mx = fmaxf(mx, __shfl_xor(mx, 16)); mx = fmaxf(mx, __shfl_xor(mx, 32));
            const float sc = 0.0625f * 1.4426950408889634f; float sum = 0.f;
#pragma unroll
            for (int kt = 0; kt < 16; ++kt)
#pragma unroll
                for (int j = 0; j < 4; ++j) { const float e = __builtin_amdgcn_exp2f((s[kt][j] - mx) * sc); s[kt][j] = e; sum += e; }
            sum += __shfl_xor(sum, 16); sum += __shfl_xor(sum, 32);
            inv[rb] = 1.f / sum;
#pragma unroll
            for (int ks = 0; ks < 8; ++ks) { u32x4 w; w.x = cvt_pk(s[2 * ks][0], s[2 * ks][1]); w.y = cvt_pk(s[2 * ks][2], s[2 * ks][3]); w.z = cvt_pk(s[2 * ks + 1][0], s[2 * ks + 1][1]); w.w = cvt_pk(s[2 * ks + 1][2], s[2 * ks + 1][3]);
                pb[rb][ks] = __builtin_bit_cast(bf16x8, w); }
        }
        lds_barrier();
        attn_stage(img, Vt + (size_t)(b * 4 + h) * 256 * 256, 256, tid);
        lds_barrier();
#pragma unroll
        for (int rb = 0; rb < 1; ++rb) {
            const size_t qrow = (size_t)b * SEQ + qb * 128 + rb * 128 + wid * 16 + fr;
            u16* orow = O + qrow * DM + h * 256 + fq * 8;
            const int prow = 8 * (fr >> 2) + (fr & 3);
#pragma unroll
            for (int dp = 0; dp < 8; ++dp) { f32x4 o0 = (f32x4){0.f, 0.f, 0.f, 0.f}, o1 = o0;
#pragma unroll
                for (int ks = 0; ks < 8; ++ks) { const u16* vp = img + (dp * 32 + prow) * KVP + ks * 32 + fq * 4;
                    { const u32x2 lo = *(const u32x2*)(vp), hi = *(const u32x2*)(vp + 16); u32x4 w; w.x = lo.x; w.y = lo.y; w.z = hi.x; w.w = hi.y; o0 = mfma16(__builtin_bit_cast(bf16x8, w), pb[rb][ks], o0); }
                    { const u32x2 lo = *(const u32x2*)(vp + 4 * KVP), hi = *(const u32x2*)(vp + 4 * KVP + 16); u32x4 w; w.x = lo.x; w.y = lo.y; w.z = hi.x; w.w = hi.y; o1 = mfma16(__builtin_bit_cast(bf16x8, w), pb[rb][ks], o1); } }
                *(u32x4*)(orow + dp * 32) = pk8(o0 * inv[rb], o1 * inv[rb]); }
        }
    }
}

constexpr int L_SM = 0;
constexpr int VQP = 68;
constexpr int L_QS = 16384, L_KS = L_QS + 128 * LP * 2, L_SS = L_KS + 128 * LP * 2, L_VT = L_SS + 128 * LP * 2, L_CT = L_VT + 64 * LP * 2;
constexpr int VSP = 264;
constexpr int L_VTF = 16384, L_KT = 86016;

struct MixArgs { const u16* proj; const float* gates; const float* convw; const float* gateb; const float* w2; const float* normg; u16* states; float* dn; float* dec; u16* y; };

DEVI void mlstm_gates(const MixArgs& a, int h, size_t tok0, float* fB, float* fI) {
    const int tid = otid();
    if (tid < 128) { const float* g = a.gates + (tok0 + tid) * 16; fI[tid] = g[h] + a.gateb[h]; fB[tid] = logsigf_(g[4 + h] + a.gateb[4 + h]); }
    lds_barrier();
    if (tid < 64) { float x0 = fB[2 * tid], x1 = fB[2 * tid + 1]; float s = x0 + x1;
#pragma unroll
        for (int o = 1; o < 64; o <<= 1) { const float t = __shfl_up(s, o); if (tid >= o) s += t; }
        fB[2 * tid] = s - x1; fB[2 * tid + 1] = s; }
    lds_barrier();
}
DEVI void mlstm_conv8(const MixArgs& a, size_t tok, int pos, int ch0, float* out) {
    float accv[8];
#pragma unroll
    for (int i = 0; i < 8; ++i) accv[i] = 0.f;
#pragma unroll
    for (int j = 0; j < 4; ++j) { if (pos - 3 + j >= 0) { const bf16x8 x = *(const bf16x8*)(a.proj + (tok - 3 + j) * 3072 + ch0);
            const f32x4 w0 = *(const f32x4*)(a.convw + j * 1024 + ch0), w1 = *(const f32x4*)(a.convw + j * 1024 + ch0 + 4);
#pragma unroll
            for (int i = 0; i < 4; ++i) { accv[i] += w0[i] * bf2f((u16)x[i]); accv[4 + i] += w1[i] * bf2f((u16)x[4 + i]); } } }
#pragma unroll
    for (int i = 0; i < 8; ++i) out[i] = siluf_(accv[i]);
}
DEVI float gla_la(const float* gl, int t, const float* w2r, float gb) { float x = gb;
#pragma unroll
    for (int r = 0; r < 16; ++r) x += gl[t * 16 + r] * w2r[r];
    return logsigf_(x) * (1.f / 16.f); }

typedef short s4v_t __attribute__((ext_vector_type(4)));
DEVI bf16x8 tr_frag(const u16* img, int RS, int r0, int c0, int lane) {
    const u16* a = img + (r0 + (lane >> 4) * 8 + ((lane & 15) >> 2)) * RS + c0 + 4 * (lane & 3);
    const s4v_t lo = __builtin_amdgcn_ds_read_tr16_b64_v4i16((LAS s4v_t*)a);
    const s4v_t hi = __builtin_amdgcn_ds_read_tr16_b64_v4i16((LAS s4v_t*)(a + 4 * RS));
    bf16x8 r; r[0] = lo[0]; r[1] = lo[1]; r[2] = lo[2]; r[3] = lo[3]; r[4] = hi[0]; r[5] = hi[1]; r[6] = hi[2]; r[7] = hi[3]; return r;
}
DEVI bf16x8 tr_frag_p(const u16* img, int RS, int r0, int n, int lane) {
    const u16* a = img + (r0 + (lane >> 4) * 8 + ((lane & 15) >> 2)) * RS + 32 * (n >> 1) + 8 * (lane & 3) + 4 * (n & 1);
    const s4v_t lo = __builtin_amdgcn_ds_read_tr16_b64_v4i16((LAS s4v_t*)a);
    const s4v_t hi = __builtin_amdgcn_ds_read_tr16_b64_v4i16((LAS s4v_t*)(a + 4 * RS));
    bf16x8 r; r[0] = lo[0]; r[1] = lo[1]; r[2] = lo[2]; r[3] = lo[3]; r[4] = hi[0]; r[5] = hi[1]; r[6] = hi[2]; r[7] = hi[3]; return r;
}

constexpr int L_RAWK = L_KT + 128 * LP * 2;
DEVI void mlstm_conv8_lds(const u16* raw, const float* convw, int t, int c8, int ch0, float* out) {
    float accv[8];
#pragma unroll
    for (int i = 0; i < 8; ++i) accv[i] = 0.f;
#pragma unroll
    for (int j = 0; j < 4; ++j) { const bf16x8 x = *(const bf16x8*)(raw + (t + j) * 128 + c8);
        const f32x4 w0 = *(const f32x4*)(convw + j * 1024 + ch0), w1 = *(const f32x4*)(convw + j * 1024 + ch0 + 4);
#pragma unroll
        for (int i = 0; i < 4; ++i) { accv[i] += w0[i] * bf2f((u16)x[i]); accv[4 + i] += w1[i] * bf2f((u16)x[4 + i]); } }
#pragma unroll
    for (int i = 0; i < 8; ++i) out[i] = siluf_(accv[i]);
}

template <int KIND>
DEVI void mix_state_phase(unsigned char* smem, const MixArgs a) {
    const int tid = otid(), wid = tid >> 6, lane = tid & 63, fr = lane & 15, fq = lane >> 4;
    float* fB = (float*)(smem + L_SM); float* fI = fB + 128; float* seg = fI + 256; float* gl = (float*)(smem + L_SM + 4096);
    u16* VTF = (u16*)(smem + L_VTF); u16* KT = (u16*)(smem + L_KT); u16* RAWK = (u16*)(smem + L_RAWK);
    u32x4 pvv[8], pkr[5]; float pg[4];
#define ST_PREF(it_) do { const int c_ = (it_) % NCH, bh_ = (it_) / NCH, h_ = bh_ & 3, b_ = bh_ >> 2; const size_t t0_ = (size_t)b_ * SEQ + c_ * CH; \
        _Pragma("unroll") for (int k = 0; k < 8; ++k) { const int i = tid + k * 512; pvv[k] = *(const u32x4*)(a.proj + (t0_ + (i >> 5)) * 3072 + 1024 + h_ * 256 + (i & 31) * 8); } \
        if (KIND == 0) { _Pragma("unroll") for (int k = 0; k < 5; ++k) { const int q = tid + k * 512, rr = q >> 4; pkr[k] = (u32x4){0u, 0u, 0u, 0u}; \
                if (q < 131 * 16 && !(c_ == 0 && rr < 3)) pkr[k] = *(const u32x4*)(a.proj + (t0_ + rr - 3) * 3072 + 512 + h_ * 128 + (q & 15) * 8); } \
            if (tid < 128) { const float* g_ = a.gates + (t0_ + tid) * 16; pg[0] = g_[h_]; pg[1] = g_[4 + h_]; } } \
        else { _Pragma("unroll") for (int k = 0; k < 4; ++k) { const int i = tid + k * 512; pkr[k] = *(const u32x4*)(a.proj + (t0_ + (i >> 4)) * 3072 + 512 + h_ * 128 + (i & 15) * 8); pg[k] = a.gates[(t0_ + (i >> 4)) * 16 + (i & 15)]; } } } while (0)
    if (obid() < 16 * NCH) ST_PREF(obid());
    for (int item = obid(); item < 16 * NCH; item += gridDim.x) {
        const int c = item % NCH, bh = item / NCH, h = bh & 3;
        lds_barrier();
#pragma unroll
        for (int k = 0; k < 8; ++k) { const int i = tid + k * 512, t = i >> 5, c8 = (i & 31) * 8; *(u32x4*)(VTF + t * VSP + c8) = pvv[k]; }
        if (KIND == 0) {
#pragma unroll
            for (int k = 0; k < 5; ++k) { const int q = tid + k * 512; if (q < 131 * 16) *(u32x4*)(RAWK + (q >> 4) * 128 + (q & 15) * 8) = pkr[k]; }
            if (tid < 128) { fI[tid] = pg[0] + a.gateb[h]; fB[tid] = logsigf_(pg[1] + a.gateb[4 + h]); }
        } else {
#pragma unroll
            for (int k = 0; k < 4; ++k) { const int i = tid + k * 512; *(u32x4*)(KT + (i >> 4) * LP + (i & 15) * 8) = pkr[k]; gl[i] = pg[k]; }
        }
        lds_barrier();
        if (item + (int)gridDim.x < 16 * NCH) ST_PREF(item + (int)gridDim.x);
        (void)c;
        if (KIND == 0) {
            if (tid < 64) { float x0 = fB[2 * tid], x1 = fB[2 * tid + 1]; float sc = x0 + x1;
#pragma unroll
                for (int o = 1; o < 64; o <<= 1) { const float t = __shfl_up(sc, o); if (tid >= o) sc += t; }
                fB[2 * tid] = sc - x1; fB[2 * tid + 1] = sc; }
            lds_barrier();
            const float bl = fB[127];
#pragma unroll 2
            for (int i = tid; i < 128 * 16; i += 512) { const int t = i >> 4, c8 = (i & 15) * 8; float v[8]; mlstm_conv8_lds(RAWK, a.convw, t, c8, 512 + h * 128 + c8, v); const float w = __expf(bl - fB[t] + fI[t]);
                u32x4 pw; pw.x = cvt_pk(v[0] * w, v[1] * w); pw.y = cvt_pk(v[2] * w, v[3] * w); pw.z = cvt_pk(v[4] * w, v[5] * w); pw.w = cvt_pk(v[6] * w, v[7] * w);
                *(u32x4*)(KT + t * LP + c8) = pw; }
        } else {
            const int ch = tid & 127, sg = tid >> 7; float w2r[16];
#pragma unroll
            for (int r = 0; r < 16; ++r) w2r[r] = a.w2[r * 512 + h * 128 + ch];
            const float gb = a.gateb[h * 128 + ch]; float ssum = 0.f;
            for (int t = sg * 32; t < sg * 32 + 32; ++t) ssum += gla_la(gl, t, w2r, gb);
            seg[sg * 128 + ch] = ssum; lds_barrier();
            float Bc = 0.f, tot = 0.f;
#pragma unroll
            for (int s2 = 0; s2 < 4; ++s2) { const float v = seg[s2 * 128 + ch]; tot += v; if (s2 < sg) Bc += v; }
            for (int t = sg * 32; t < sg * 32 + 32; ++t) { Bc += gla_la(gl, t, w2r, gb);
                const float kv = bf2f(KT[t * LP + ch]); KT[t * LP + ch] = f2bf(kv * __expf(tot - Bc)); }
            if (sg == 0) a.dec[(size_t)item * 128 + ch] = __expf(tot);
        }
        lds_barrier();
        f32x4 acc[2][8];
#pragma unroll
        for (int m = 0; m < 2; ++m)
#pragma unroll
            for (int n = 0; n < 8; ++n) acc[m][n] = (f32x4){0.f, 0.f, 0.f, 0.f};
#pragma unroll
        for (int ks = 0; ks < 4; ++ks) { bf16x8 af[2];
#pragma unroll
            for (int m = 0; m < 2; ++m) af[m] = tr_frag(VTF, VSP, ks * 32, wid * 32 + m * 16, lane);
#pragma unroll
            for (int n = 0; n < 8; ++n) { const bf16x8 bf = tr_frag_p(KT, LP, ks * 32, n, lane);
#pragma unroll
                for (int m = 0; m < 2; ++m) acc[m][n] = mfma16(bf, af[m], acc[m][n]); } }
        u16* st = a.states + (size_t)item * 256 * 128;
#pragma unroll
        for (int m = 0; m < 2; ++m)
#pragma unroll
            for (int n = 0; n < 8; n += 2) *(u32x4*)(st + (wid * 32 + m * 16 + fr) * 128 + n * 16 + fq * 8) = pk8(acc[m][n], acc[m][n + 1]);
        if (KIND == 0 && tid < 128) { float sum = 0.f; for (int t = 0; t < 128; ++t) sum += bf2f(KT[t * LP + tid]); a.dn[(size_t)item * 128 + tid] = sum; a.dec[(size_t)item * 128 + tid] = __expf(fB[127]); }
    }
#undef ST_PREF
}

DEVI void mix_scan_phase(const MixArgs a, bool with_n) {
    const int gt = obid() * 512 + otid(), nthr = gridDim.x * 512;
    for (int e = gt; e < 16 * 256 * 32; e += nthr) { const int dk4 = (e & 31) * 4, dv = (e >> 5) & 255, bh = e >> 13;
        f32x4 run = (f32x4){0.f, 0.f, 0.f, 0.f};
#pragma unroll 16
        for (int c = 0; c < NCH; ++c) { const size_t it = (size_t)bh * NCH + c; u16* sp = a.states + (it * 256 + dv) * 128 + dk4;
            const f32x4 d = *(const f32x4*)(a.dec + it * 128 + dk4); const bf16x4 x = *(const bf16x4*)sp;
            *(u32x2*)sp = pk4(run);
#pragma unroll
            for (int j = 0; j < 4; ++j) run[j] = d[j] * run[j] + bf2f((u16)x[j]); } }
    if (with_n) for (int e = gt; e < 16 * 128; e += nthr) { const int dk = e & 127, bh = e >> 7; float run = 0.f;
        for (int c = 0; c < NCH; ++c) { const size_t o = ((size_t)bh * NCH + c) * 128 + dk; const float x = a.dn[o], d = a.dec[o]; a.dn[o] = run; run = d * run + x; } }
}

template <int KIND>
DEVI void mix_out_phase(unsigned char* smem, const MixArgs a) {
    const int tid = otid(), wid = tid >> 6, lane = tid & 63, fr = lane & 15, fq = lane >> 4;
    float* fB = (float*)(smem + L_SM); float* fI = fB + 128; float* fN = fI + 128; float* seg = fN + 128; float* gl = (float*)(smem + L_SM + 4096);
    u16* QS = (u16*)(smem + L_QS); u16* KS = (u16*)(smem + L_KS); u16* SS = (u16*)(smem + L_SS); u16* VT = (u16*)(smem + L_VT); u16* CT = (u16*)(smem + L_CT);
    u16* RAW = (u16*)(smem + L_SS);
    const int trow = wid * 16 + fr;
    u32x4 prq[9]; float pg[4];
#define OUT_PREF(it_) do { const int c_ = (it_) % NCH, bh_ = (it_) / NCH, h_ = bh_ & 3, b_ = bh_ >> 2; const size_t t0_ = (size_t)b_ * SEQ + c_ * CH; \
        if (KIND == 0) { _Pragma("unroll") for (int k = 0; k < 9; ++k) { const int q = tid + k * 512, rr = q >> 5; prq[k] = (u32x4){0u, 0u, 0u, 0u}; \
                if (q < 131 * 32 && !(c_ == 0 && rr < 3)) prq[k] = *(const u32x4*)(a.proj + (t0_ + rr - 3) * 3072 + ((q >> 4) & 1) * 512 + h_ * 128 + (q & 15) * 8); } \
            if (tid < 128) { const float* g_ = a.gates + (t0_ + tid) * 16; pg[0] = g_[h_]; pg[1] = g_[4 + h_]; pg[2] = a.dn[(size_t)(it_) * 128 + tid]; } } \
        else { _Pragma("unroll") for (int k = 0; k < 4; ++k) { const int i = tid + k * 512; const u16* pr_ = a.proj + (t0_ + (i >> 4)) * 3072 + h_ * 128 + (i & 15) * 8; \
                prq[k] = *(const u32x4*)pr_; prq[4 + k] = *(const u32x4*)(pr_ + 512); pg[k] = a.gates[(t0_ + (i >> 4)) * 16 + (i & 15)]; } } } while (0)
    if (KIND == 1 && obid() < 16 * NCH) OUT_PREF(obid());
    for (int item = obid(); item < 16 * NCH; item += gridDim.x) {
        const int c = item % NCH, bh = item / NCH, h = bh & 3, b = bh >> 2; const size_t tok0 = (size_t)b * SEQ + c * CH;
        if (KIND == 0) OUT_PREF(item);
        const size_t tok = tok0 + trow;
        u32x4 pv[1][2], pc[1][2];
#define MIX_PREF(qq, bb) do { _Pragma("unroll") for (int k = 0; k < 2; ++k) { const int i = tid + k * 512; \
            pv[bb][k] = *(const u32x4*)(a.proj + (tok0 + (i >> 3)) * 3072 + 1024 + h * 256 + (qq) * 64 + (i & 7) * 8); \
            pc[bb][k] = *(const u32x4*)(a.states + ((size_t)item * 256 + (qq) * 64 + (i >> 4)) * 128 + (i & 15) * 8); } } while (0)
        MIX_PREF(0, 0);
        lds_barrier();
        if (KIND == 0) {
#pragma unroll
            for (int k = 0; k < 9; ++k) { const int q = tid + k * 512; if (q < 131 * 32) *(u32x4*)(RAW + ((q >> 4) & 1) * (131 * 128) + (q >> 5) * 128 + (q & 15) * 8) = prq[k]; }
            if (tid < 128) { fI[tid] = pg[0] + a.gateb[h]; fB[tid] = logsigf_(pg[1] + a.gateb[4 + h]); fN[tid] = pg[2]; }
        } else {
#pragma unroll
            for (int k = 0; k < 4; ++k) { const int i = tid + k * 512; *(u32x4*)(QS + (i >> 4) * LP + (i & 15) * 8) = prq[k]; *(u32x4*)(KS + (i >> 4) * LP + (i & 15) * 8) = prq[4 + k]; gl[i] = pg[k]; }
        }
        lds_barrier();
        if (KIND == 1 && item + (int)gridDim.x < 16 * NCH) OUT_PREF(item + (int)gridDim.x);
        if (KIND == 0) {
            if (tid < 64) { float x0 = fB[2 * tid], x1 = fB[2 * tid + 1]; float sc = x0 + x1;
#pragma unroll
                for (int o = 1; o < 64; o <<= 1) { const float t = __shfl_up(sc, o); if (tid >= o) sc += t; }
                fB[2 * tid] = sc - x1; fB[2 * tid + 1] = sc; }
#pragma unroll 2
            for (int i = tid; i < 128 * 32; i += 512) { const int t = (i >> 4) & 127, c8 = (i & 15) * 8, isk = i >> 11; float v[8];
                mlstm_conv8_lds(RAW + isk * (131 * 128), a.convw, t, c8, isk * 512 + h * 128 + c8, v); const float sc = isk ? 1.f : 0.08838834764831845f;
                u32x4 w; w.x = cvt_pk(v[0] * sc, v[1] * sc); w.y = cvt_pk(v[2] * sc, v[3] * sc); w.z = cvt_pk(v[4] * sc, v[5] * sc); w.w = cvt_pk(v[6] * sc, v[7] * sc);
                *(u32x4*)((isk ? KS : QS) + t * LP + c8) = w; }
        } else {
            const int ch = tid & 127, sg = tid >> 7; float w2r[16];
#pragma unroll
            for (int r = 0; r < 16; ++r) w2r[r] = a.w2[r * 512 + h * 128 + ch];
            const float gb = a.gateb[h * 128 + ch]; float ssum = 0.f;
            for (int t = sg * 32; t < sg * 32 + 32; ++t) ssum += gla_la(gl, t, w2r, gb);
            seg[sg * 128 + ch] = ssum; lds_barrier();
            float Bc = 0.f;
#pragma unroll
            for (int s2 = 0; s2 < 4; ++s2) { const float v = seg[s2 * 128 + ch]; if (s2 < sg) Bc += v; }
            for (int t = sg * 32; t < sg * 32 + 32; ++t) { Bc += gla_la(gl, t, w2r, gb);
                QS[t * LP + ch] = f2bf(bf2f(QS[t * LP + ch]) * 0.08838834764831845f * __expf(Bc)); KS[t * LP + ch] = f2bf(bf2f(KS[t * LP + ch]) * __expf(-Bc)); }
        }
        lds_barrier();
        bf16x8 qa[4];
#pragma unroll
        for (int ks = 0; ks < 4; ++ks) qa[ks] = *(const bf16x8*)(QS + trow * LP + ks * 32 + fq * 8);
        float rowsum = 0.f; const float bt = (KIND == 0) ? fB[trow] : 0.f;
        const int nmax = wid | 1;
        for (int n = 0; n <= nmax; ++n) { f32x4 s = (f32x4){0.f, 0.f, 0.f, 0.f};
            if (n <= wid) {
#pragma unroll
                for (int ks = 0; ks < 4; ++ks) { const bf16x8 kb = *(const bf16x8*)(KS + (n * 16 + fr) * LP + ks * 32 + fq * 8); s = mfma16(kb, qa[ks], s); }
#pragma unroll
                for (int j = 0; j < 4; ++j) { const int sc = n * 16 + fq * 4 + j;
                    if (sc <= trow) { if (KIND == 0) s[j] *= __expf(bt - fB[sc] + fI[sc]); } else s[j] = 0.f;
                    rowsum += s[j]; } }
            *(u32x2*)(SS + trow * LP + n * 16 + fq * 4) = pk4(s); }
        bf16x8 gtv[8];
#pragma unroll
        for (int i = 0; i < 8; ++i) gtv[i] = *(const bf16x8*)(a.proj + tok * 3072 + 2048 + h * 256 + i * 32 + fq * 8);
        f32x4 o[16];
#pragma unroll
        for (int qv = 0; qv < 4; ++qv) {
            lds_barrier();
#pragma unroll
            for (int k = 0; k < 2; ++k) { const int i = tid + k * 512; *(u32x4*)(VT + (i >> 3) * VQP + (i & 7) * 8) = pv[0][k]; *(u32x4*)(CT + (i >> 4) * LP + (i & 15) * 8) = pc[0][k]; }
            lds_barrier();
            if (qv < 3) MIX_PREF(qv + 1, 0);
#pragma unroll
            for (int n = 0; n < 4; ++n) { f32x4 ac = (f32x4){0.f, 0.f, 0.f, 0.f};
#pragma unroll
                for (int ks = 0; ks < 4; ++ks) { const bf16x8 cb = *(const bf16x8*)(CT + (32 * (n >> 1) + 8 * (fr >> 2) + 4 * (n & 1) + (fr & 3)) * LP + ks * 32 + fq * 8); ac = mfma16(cb, qa[ks], ac); }
                if (KIND == 0) ac = ac * __expf(bt);
                for (int ks = 0; ks <= (wid >> 1); ++ks) { const bf16x8 sa = *(const bf16x8*)(SS + trow * LP + ks * 32 + fq * 8); const bf16x8 vb = tr_frag_p(VT, VQP, ks * 32, n, lane); ac = mfma16(vb, sa, ac); }
                o[qv * 4 + n] = ac; }
        }
#undef MIX_PREF
        float scale = 1.f;
        if (KIND == 0) { float qn = 0.f;
#pragma unroll
            for (int i = 0; i < 32; ++i) qn += bf2f(QS[trow * LP + fq * 32 + i]) * fN[fq * 32 + i];
            qn += __shfl_xor(qn, 16); qn += __shfl_xor(qn, 32);
            rowsum += __shfl_xor(rowsum, 16); rowsum += __shfl_xor(rowsum, 32);
            const float den = rowsum + __expf(bt) * qn; scale = 1.f / fmaxf(fabsf(den), 1.f); }
        float ssq = 0.f;
#pragma unroll
        for (int i = 0; i < 16; ++i) { o[i] = o[i] * scale; ssq += o[i][0] * o[i][0] + o[i][1] * o[i][1] + o[i][2] * o[i][2] + o[i][3] * o[i][3]; }
        ssq += __shfl_xor(ssq, 16); ssq += __shfl_xor(ssq, 32);
        const float rs = rsqrtf(ssq * (1.f / 256.f) + 1e-6f);
#pragma unroll
        for (int pp = 0; pp < 8; ++pp) { const int col = h * 256 + pp * 32 + fq * 8; const f32x4 g0 = *(const f32x4*)(a.normg + col), g1 = *(const f32x4*)(a.normg + col + 4); f32x4 v0, v1;
#pragma unroll
            for (int j = 0; j < 4; ++j) { const float x0 = bf2f((u16)gtv[pp][j]), x1 = bf2f((u16)gtv[pp][4 + j]);
                v0[j] = o[2 * pp][j] * rs * g0[j] * (KIND == 0 ? sigmoidf_(x0) : siluf_(x0)); v1[j] = o[2 * pp + 1][j] * rs * g1[j] * (KIND == 0 ? sigmoidf_(x1) : siluf_(x1)); }
            *(u32x4*)(a.y + tok * DM + col) = pk8(v0, v1); }
    }
}

DEVI void s5_tables(const Params& p) {
    float* apow = (float*)(p.ws + OFF_APOW); float* bbo = (float*)(p.ws + OFF_BB);
    for (int e = obid() * 512 + otid(); e < 64 * 64; e += gridDim.x * 512) { const int g = e >> 6;
        const float lr = p.in[18][e], li = p.in[19][e]; const float dt = expf(p.in[20][g]);
        const double dlr = (double)lr * (double)dt, dli = (double)li * (double)dt;
        for (int tau = 0; tau < 34; ++tau) { const double mg = exp(dlr * tau), an = dli * tau; apow[((size_t)e * 34 + tau) * 2] = (float)(mg * cos(an)); apow[((size_t)e * 34 + tau) * 2 + 1] = (float)(mg * sin(an)); }
        const double are = exp(dlr) * cos(dli), aim = exp(dlr) * sin(dli), den = (double)lr * lr + (double)li * li;
        const double zre = ((are - 1.0) * lr + aim * li) / den, zim = (aim * lr - (are - 1.0) * li) / den;
        for (int hh = 0; hh < 16; ++hh) { const double br = p.in[21][(size_t)e * 16 + hh], bi = p.in[22][(size_t)e * 16 + hh];
            bbo[((size_t)e * 16 + hh) * 2] = (float)(zre * br - zim * bi); bbo[((size_t)e * 16 + hh) * 2 + 1] = (float)(zre * bi + zim * br); } }
}
DEVI void s5_kc(const Params& p) {
    const float* apow = (const float*)(p.ws + OFF_APOW); const float* bb = (const float*)(p.ws + OFF_BB); float* kc = (float*)(p.ws + OFF_KC);
    const int NE = 64 * 32 * 256, G2 = gridDim.x >> 1; const bool busy = obid() < G2; const int lo = busy ? (NE / 3) * 2 : 0, hi = busy ? NE : (NE / 3) * 2, w = busy ? obid() : obid() - G2;
    for (int e = lo + w * 512 + otid(); e < hi; e += (gridDim.x - G2) * 512 * (busy ? 0 : 1) + G2 * 512 * (busy ? 1 : 0)) { const int h2 = e & 15, hh = (e >> 4) & 15, tau = (e >> 8) & 31, g = e >> 13; float s = 0.f;
        for (int pp = 0; pp < 64; ++pp) { const size_t gp = (size_t)g * 64 + pp; const float ar = apow[(gp * 34 + tau) * 2], ai = apow[(gp * 34 + tau) * 2 + 1];
            const float br = bb[(gp * 16 + h2) * 2], bi = bb[(gp * 16 + h2) * 2 + 1]; const float cr = p.in[23][((size_t)g * 16 + hh) * 64 + pp], ci = p.in[24][((size_t)g * 16 + hh) * 64 + pp];
            const float xr = ar * br - ai * bi, xi = ar * bi + ai * br; s += cr * xr - ci * xi; }
        kc[e] = s; }
}
DEVI void s5_fill(const Params& p) {
    const float* apow = (const float*)(p.ws + OFF_APOW); const float* bb = (const float*)(p.ws + OFF_BB); const float* kc = (const float*)(p.ws + OFF_KC);
    u16* bty = (u16*)(p.ws + OFF_BTY); u16* btg = (u16*)(p.ws + OFF_BTG);
    const int gt = obid() * 512 + otid(), nthr = gridDim.x * 512;
    for (int e = gt; e < 64 * 512 * 80; e += nthr) { const int k8 = (e % 80) * 8, n = (e / 80) & 511, g = e / (80 * 512), t = n >> 4, hh = n & 15; float v[8];
        if (k8 < 512) { const int s = k8 >> 4, h0 = k8 & 15;
#pragma unroll
            for (int j = 0; j < 8; ++j) { float x = 0.f; if (s <= t) { x = kc[(((size_t)g * 32 + (t - s)) * 16 + hh) * 16 + h0 + j]; if (s == t && h0 + j == hh) x += p.in[25][g * 16 + hh]; } v[j] = x; }
        } else { const int q0 = k8 - 512;
#pragma unroll
            for (int j = 0; j < 8; ++j) { const int q = q0 + j, pp = q & 63; const size_t gp = (size_t)g * 64 + pp; const float ar = apow[(gp * 34 + t + 1) * 2], ai = apow[(gp * 34 + t + 1) * 2 + 1];
                const float cr = p.in[23][((size_t)g * 16 + hh) * 64 + pp], ci = p.in[24][((size_t)g * 16 + hh) * 64 + pp]; v[j] = (q < 64) ? (cr * ar - ci * ai) : -(cr * ai + ci * ar); } }
        u32x4 w; w.x = cvt_pk(v[0], v[1]); w.y = cvt_pk(v[2], v[3]); w.z = cvt_pk(v[4], v[5]); w.w = cvt_pk(v[6], v[7]);
        *(u32x4*)(bty + ((size_t)g * 512 + n) * 640 + k8) = w; }
    for (int e = gt; e < 64 * 256 * 64; e += nthr) { const int k8 = (e & 63) * 8, n = (e >> 6) & 255, g = e >> 14, s = k8 >> 4, h0 = k8 & 15; float v[8];
#pragma unroll
        for (int j = 0; j < 8; ++j) { float x = 0.f; if (n < 128) { const int pp = n & 63; const size_t gp = (size_t)g * 64 + pp; const float ar = apow[(gp * 34 + 31 - s) * 2], ai = apow[(gp * 34 + 31 - s) * 2 + 1];
                const float br = bb[(gp * 16 + h0 + j) * 2], bi = bb[(gp * 16 + h0 + j) * 2 + 1]; x = (n < 64) ? (ar * br - ai * bi) : (ar * bi + ai * br); } v[j] = x; }
        u32x4 w; w.x = cvt_pk(v[0], v[1]); w.y = cvt_pk(v[2], v[3]); w.z = cvt_pk(v[4], v[5]); w.w = cvt_pk(v[6], v[7]);
        *(u32x4*)(btg + ((size_t)g * 256 + n) * 512 + k8) = w; }
}
DEVI void s5_scan(const Params& p) {
    const float* apow = (const float*)(p.ws + OFF_APOW); const float* send = (const float*)(p.ws + OFF_SEND); u16* ue = (u16*)(p.ws + OFF_UEXT);
    for (int e = obid() * 512 + otid(); e < 64 * 4 * 64; e += gridDim.x * 512) { const int pp = e & 63, b = (e >> 6) & 3, g = e >> 8;
        const float ar = apow[(((size_t)g * 64 + pp) * 34 + 32) * 2], ai = apow[(((size_t)g * 64 + pp) * 34 + 32) * 2 + 1]; float rr = 0.f, ri = 0.f;
#pragma unroll 16
        for (int c = 0; c < 256; ++c) { const size_t row = (size_t)g * 1024 + b * 256 + c; const float er = send[row * 128 + pp], ei = send[row * 128 + 64 + pp];
            ue[row * 640 + 512 + pp] = f2bf(rr); ue[row * 640 + 576 + pp] = f2bf(ri);
            const float nr = ar * rr - ai * ri + er, ni = ar * ri + ai * rr + ei; rr = nr; ri = ni; } }
}


#define XB_TMO      128
#define XB_XCNT(j)  (256  + 64 * (j))
#define XB_XSUB(j)  (1280 + 64 * (j))
#define XB_XGEN(j)  (2304 + 64 * (j))
#define XB_TOP      3328
#define XB_TOPGEN   3392
#define XCD_BAR_WORDS 3456
#define XB_SPIN_CAP (1u << 18)
DEVI unsigned xb_ld(unsigned* p)              { return __hip_atomic_load(p, __ATOMIC_RELAXED, __HIP_MEMORY_SCOPE_AGENT); }
DEVI unsigned xb_add(unsigned* p, unsigned v) { return __hip_atomic_fetch_add(p, v, __ATOMIC_RELAXED, __HIP_MEMORY_SCOPE_AGENT); }
DEVI unsigned xb_xcc_id() { return (unsigned)__builtin_amdgcn_s_getreg((3 << 11) | 20) & 0xFu; }
#define XB_SPIN(cond, bar) do { unsigned _sp = 0; while (cond) { __builtin_amdgcn_s_sleep(1); \
    if ((++_sp & 255u) == 0u) { if (xb_ld(&(bar)[XB_TMO])) break; if (_sp > XB_SPIN_CAP) { atomicAdd(&(bar)[XB_TMO], 1u); break; } } } } while (0)
struct XcdBarrier { unsigned* bar; unsigned x; volatile LAS unsigned* st; };
DEVI XcdBarrier xcd_barrier_post(unsigned* bar, volatile LAS unsigned* st) {
    XcdBarrier b; b.bar = bar; b.x = xb_xcc_id(); b.st = st;
    if (threadIdx.x == 0) (void)xb_add(&bar[XB_XCNT(b.x)], 1u);
    return b;
}
DEVI void xcd_barrier_complete(unsigned* bar, unsigned x, unsigned& nloc, unsigned& nx) {
    const unsigned G = gridDim.x * gridDim.y * gridDim.z;
    unsigned sum, cnt, mine, sp = 0u;
    for (;;) {
        sum = 0u; cnt = 0u; mine = 0u;
#pragma unroll
        for (unsigned j = 0; j < 16; ++j) { const unsigned c = xb_ld(&bar[XB_XCNT(j)]); sum += c; cnt += (c > 0u) ? 1u : 0u; mine = (j == x) ? c : mine; }
        if (sum == G) break;
        __builtin_amdgcn_s_sleep(1);
        if ((++sp & 255u) == 0u) { if (xb_ld(&bar[XB_TMO])) break; if (sp > XB_SPIN_CAP) { atomicAdd(&bar[XB_TMO], 1u); break; } }
    }
    nloc = mine > 0u ? mine : 1u; nx = cnt > 0u ? cnt : 1u;
}
DEVI void xcd_barrier(const XcdBarrier& b) {
    asm volatile("s_waitcnt vmcnt(0)" ::: "memory");
    __syncthreads();
    if (threadIdx.x == 0) {
        unsigned* bar = b.bar;
        __builtin_amdgcn_s_waitcnt(0);
        unsigned nloc = b.st[0], nx = b.st[1];
        if (nloc == 0u) { xcd_barrier_complete(bar, b.x, nloc, nx); b.st[0] = nloc; b.st[1] = nx; }
        const unsigned old = xb_add(&bar[XB_XSUB(b.x)], 1u);
        const unsigned gen = old / nloc;
        if (old + 1u == (gen + 1u) * nloc) {
            __builtin_amdgcn_fence(__ATOMIC_RELEASE, "agent");
            asm volatile("s_waitcnt vmcnt(0)" ::: "memory");
            const unsigned og = xb_add(&bar[XB_TOP], 1u);
            const unsigned tg = og / nx;
            if (og + 1u == (tg + 1u) * nx) xb_add(&bar[XB_TOPGEN], 1u);
            else XB_SPIN(xb_ld(&bar[XB_TOPGEN]) == tg, bar);
            __builtin_amdgcn_fence(__ATOMIC_ACQUIRE, "agent");
            xb_add(&bar[XB_XGEN(b.x)], 1u);
            asm volatile("s_waitcnt vmcnt(0)" ::: "memory");
        } else {
            XB_SPIN(xb_ld(&bar[XB_XGEN(b.x)]) == gen, bar);
            __builtin_amdgcn_fence(__ATOMIC_ACQUIRE, "agent");
            asm volatile("s_waitcnt vmcnt(0)" ::: "memory");
        }
    }
    __syncthreads();
}

__global__ void __launch_bounds__(512, 2) fwd_megakernel(Params p) {
    extern __shared__ __attribute__((aligned(16))) unsigned char smem[];
    cg::grid_group grid = cg::this_grid();
    LAS unsigned char* lds = (LAS unsigned char*)smem;
    unsigned char* ws = p.ws;
    u16* HN = (u16*)(ws + OFF_HN); u16* PROJ = (u16*)(ws + OFF_PROJ); float* GATES = (float*)(ws + OFF_GATES);
    float* H = p.out;
    unsigned* bar = (unsigned*)(ws + OFF_BAR);
    volatile LAS unsigned* st = (volatile LAS unsigned*)(lds + LDS_MAIN);
    if (blockIdx.x == 0) for (int i = threadIdx.x; i < XCD_BAR_WORDS; i += 512) bar[i] = 0u;
    if (threadIdx.x == 0) { st[0] = 0u; st[1] = 0u; }
    grid.sync();
    const XcdBarrier xb = xcd_barrier_post(bar, st);

    { int base = 0;
      for (int job = 0; job < 33; ++job) { const float* src; const float* gk; int K, N, Npad, mode; u16* dst; conv_job(p, job, src, K, N, dst, Npad, mode, gk);
        const int G = gridDim.x; int first = ((int)blockIdx.x - base) % G; if (first < 0) first += G;
        convT(src, K, N, dst, Npad, mode, gk, (float*)smem, first); base += (K / 64) * (Npad / 64); } }
    rms_phase(p.in[1], p.in[5], (u16*)(ws + OFF_MEMN), 1024);
    s5_tables(p);
    xcd_barrier(xb);
    { Gemm g{(const u16*)(ws + OFF_MEMN), (const u16*)(ws + OFF_W_XKV), 1024, 1024, 1024, 4, 8, 4, 0, 2048ull * 1024};
      gemm_phase(lds, g, EpiKV{(u16*)(ws + OFF_KBUF), (u16*)(ws + OFF_VT)}); }
    s5_kc(p);
    prep_phase(p.in[0], HN, (float*)(ws + OFF_SSQ));
    xcd_barrier(xb);

#pragma unroll 1
    for (int layer = 0; layer < 4; ++layer) {
        const int kind = layer % 3, j = layer / 3;
        const float* hin = layer == 0 ? p.in[0] : H;
        float* SSQ = (float*)(ws + OFF_SSQ) + (size_t)(3 * layer) * T_TOK * 4;
        if (kind != 2) {
            MixArgs a; a.proj = PROJ; a.gates = GATES; a.states = (u16*)(ws + OFF_STATES); a.dn = (float*)(ws + OFF_DN); a.dec = (float*)(ws + OFF_DEC); a.y = HN;
            const u16* wout;
            if (kind == 0) { a.convw = p.in[8] + j * 4096; a.gateb = p.in[9] + j * 8; a.w2 = nullptr; a.normg = p.in[10] + j * 1024; wout = (const u16*)(ws + OFF_W_AOUT + j * SZ_SQ);
                Gemm g{HN, (const u16*)(ws + OFF_W_AIN + j * SZ_AIN), 1024, 1024, 1024, 128, 13, 1, 0, 0}; gemm_phase(lds, g, EpiInProj{PROJ, GATES, 8, SSQ}); }
            else { a.convw = nullptr; a.gateb = p.in[14]; a.w2 = p.in[13]; a.normg = p.in[15]; wout = (const u16*)(ws + OFF_W_BOUT);
                Gemm g{HN, (const u16*)(ws + OFF_W_BIN), 1024, 1024, 1024, 128, 13, 1, 0, 0}; gemm_phase(lds, g, EpiInProj{PROJ, GATES, 16, SSQ}); }
            xcd_barrier(xb);
            if (kind == 0) mix_state_phase<0>(smem, a); else mix_state_phase<1>(smem, a);
            xcd_barrier(xb);
            mix_scan_phase(a, kind == 0);
            {
                Gemm g1{(const u16*)(ws + OFF_KBUF + layer * SZ_SQ), (const u16*)(ws + OFF_W_XQ + layer * SZ_SQ), 1024, 1024, 256, 1, 4, 16, 262144, 0}; g1.split = 1; g1.sA_lo = 256; g1.sB_lo = 256;
                gemm_phase(lds, g1, EpiG{(u16*)(ws + OFF_GBT)});
                Gemm g2{(const u16*)(ws + OFF_W_XO + layer * SZ_SQ), (const u16*)(ws + OFF_VT + layer * SZ_SQ), 1024, 1024, 256, 4, 1, 16, 0, 262144}; g2.split = 1; g2.sA_lo = 256; g2.sB_lo = 256; g2.wg_off = 128;
                gemm_phase(lds, g2, EpiVW{(u16*)(ws + OFF_VWBT)});
            }
            xcd_barrier(xb);
            if (kind == 0) mix_out_phase<0>(smem, a); else mix_out_phase<1>(smem, a);
            xcd_barrier(xb);
            { Gemm g{HN, wout, 1024, 1024, 1024, 128, 4, 1, 0, 0}; gemm_phase(lds, g, EpiResid{hin, H, (u16*)(ws + OFF_HB), SSQ + 4 * T_TOK}); }
        } else {
            { Gemm g{HN, (const u16*)(ws + OFF_W_CIN), 1024, 1024, 1024, 128, 4, 1, 0, 0}; gemm_phase(lds, g, EpiUext{(u16*)(ws + OFF_UEXT), SSQ}); }
            s5_fill(p);
            xcd_barrier(xb);
            { Gemm g{(const u16*)(ws + OFF_UEXT), (const u16*)(ws + OFF_BTG), 640, 512, 512, 4, 1, 64, 1024ull * 640, 256ull * 512}; gemm_phase(lds, g, EpiSend{(float*)(ws + OFF_SEND)}); }
            xcd_barrier(xb);
            s5_scan(p);
            {
                Gemm g1{(const u16*)(ws + OFF_KBUF + layer * SZ_SQ), (const u16*)(ws + OFF_W_XQ + layer * SZ_SQ), 1024, 1024, 256, 1, 4, 16, 262144, 0}; g1.split = 1; g1.sA_lo = 256; g1.sB_lo = 256;
                gemm_phase(lds, g1, EpiG{(u16*)(ws + OFF_GBT)});
                Gemm g2{(const u16*)(ws + OFF_W_XO + layer * SZ_SQ), (const u16*)(ws + OFF_VT + layer * SZ_SQ), 1024, 1024, 256, 4, 1, 16, 0, 262144}; g2.split = 1; g2.sA_lo = 256; g2.sB_lo = 256; g2.wg_off = 128;
                gemm_phase(lds, g2, EpiVW{(u16*)(ws + OFF_VWBT)});
            }
            xcd_barrier(xb);
            { Gemm g{(const u16*)(ws + OFF_UEXT), (const u16*)(ws + OFF_BTY), 640, 640, 640, 4, 2, 64, 1024ull * 640, 512ull * 640}; gemm_phase(lds, g, EpiS5Y{HN}); }
            xcd_barrier(xb);
            { Gemm g{HN, (const u16*)(ws + OFF_W_CGATE), 1024, 1024, 1024, 128, 4, 1, 0, 0}; gemm_phase(lds, g, EpiS5Gate{HN, p.in[27], (u16*)(ws + OFF_Z)}); }
            xcd_barrier(xb);
            { Gemm g{(const u16*)(ws + OFF_Z), (const u16*)(ws + OFF_W_COUT), 1024, 1024, 1024, 128, 4, 1, 0, 0}; gemm_phase(lds, g, EpiResid{hin, H, (u16*)(ws + OFF_HB), SSQ + 4 * T_TOK}); }
        }
        xcd_barrier(xb);
        { Gemm g{(const u16*)(ws + OFF_HB), (const u16*)(ws + OFF_GBT), 1024, 1024, 1024, 128, 4, 1, 0, 0}; g.pmsh = 5; g.sBpm = 1024ull * 1024;
          gemm_phase(lds, g, EpiSoftmax{(u16*)(ws + OFF_XO), SSQ + 4 * T_TOK}); }
        xcd_barrier(xb);
        { Gemm g{(const u16*)(ws + OFF_XO), (const u16*)(ws + OFF_VWBT), 1024, 1024, 1024, 128, 4, 1, 0, 0}; g.pmsh = 5; g.sBpm = 1024ull * 1024;
          gemm_phase(lds, g, EpiResid{H, H, HN, SSQ + 8 * T_TOK}); }
        xcd_barrier(xb);
        { Gemm g{HN, (const u16*)(ws + OFF_W_FGU + layer * SZ_FGU), 1024, 1024, 1024, 128, 22, 1, 0, 0}; gemm_phase(lds, g, EpiSwiglu{PROJ, SSQ + 8 * T_TOK}); }
        xcd_barrier(xb);
        { Gemm g{PROJ, (const u16*)(ws + OFF_W_FD + layer * SZ_FD), 2816, 2816, 2816, 128, 4, 1, 0, 0}; gemm_phase(lds, g, EpiResid{H, H, HN, SSQ + 12 * T_TOK}); }
        xcd_barrier(xb);
    }
    rms_final(H, p.in[6]);
}

extern "C" void kernel_launch(void* const* d_in, const int* in_sizes, int n_in, void* d_out, int out_size, void* d_ws, size_t ws_size, hipStream_t stream) {
    static int grid_blocks = 0;
    if (grid_blocks == 0) {
        if (n_in != 35 || ws_size < WS_END) { fprintf(stderr, "kernel_launch: unexpected n_in %d or ws_size %zu (need %zu)\n", n_in, ws_size, (size_t)WS_END); grid_blocks = -1; return; }
        int dev = 0, cus = 0, per_cu = 0;
        hipGetDevice(&dev);
        hipDeviceGetAttribute(&cus, hipDeviceAttributeMultiprocessorCount, dev);
        hipFuncSetAttribute((const void*)fwd_megakernel, hipFuncAttributeMaxDynamicSharedMemorySize, LDS_BYTES);
        hipOccupancyMaxActiveBlocksPerMultiprocessor(&per_cu, (const void*)fwd_megakernel, 512, LDS_BYTES);
        if (per_cu < 1) per_cu = 1;
        grid_blocks = cus * per_cu;
    }
    if (grid_blocks < 0) return;
    Params p{};
    for (int i = 0; i < 35; ++i) p.in[i] = (const float*)d_in[i];
    p.out = (float*)d_out; p.ws = (unsigned char*)d_ws;
    void* args[] = {&p};
    hipError_t e = hipLaunchCooperativeKernel((const void*)fwd_megakernel, dim3(grid_blocks), dim3(512), args, LDS_BYTES, stream);
    if (e != hipSuccess) fprintf(stderr, "cooperative launch failed: %s (grid %d)\n", hipGetErrorString(e), grid_blocks);
}
```
